# Optimizing an MI355X kernel written in HIP

```python
import math
import jax, jax.numpy as jnp
from jax import lax
import numpy as np

D_MODEL = 1024
BATCH = 16
SEQ = 2048
DEPTH = 2

HEAD_DIM = 64
N_HEADS = D_MODEL // HEAD_DIM
A_HEADS = N_HEADS // 2
A_BRANCHES = ((128, 1), (512, 4), (2048, 16))
B_HEADS = N_HEADS - A_HEADS
B_Q_RANK = D_MODEL // 4
IDX_HEADS = 8
IDX_DIM = 32
TOPK_MAX = 256
C_HEADS = N_HEADS
C_KV_HEADS = C_HEADS // 8
C_WINDOW = 128
D_FF = 2816
NUM_BUCKETS = 32
MAX_DISTANCE = 2048
BLOCK = 128
EPS = 1e-6
N_EVEN = (DEPTH + 1) // 2
N_ODD = DEPTH // 2
A_W = A_HEADS * HEAD_DIM
B_W = B_HEADS * HEAD_DIM
EVEN_SIZES = (A_W, A_W, A_W, B_Q_RANK, B_W, B_W, IDX_DIM, IDX_HEADS)
EVEN_IN = sum(EVEN_SIZES)
ODD_SIZES = (C_HEADS * HEAD_DIM, C_KV_HEADS * HEAD_DIM, C_KV_HEADS * HEAD_DIM)
ODD_IN = sum(ODD_SIZES)

kernel_name = "hybrid_dilated_dsa_swa_macaron"

F32 = jnp.float32


def _offsets(sizes):
    out, acc = [], 0
    for s in sizes[:-1]:
        acc += s
        out.append(acc)
    return out


def rmsnorm(x, g):
    xf = x.astype(F32)
    y = xf * lax.rsqrt(jnp.mean(xf * xf, axis=-1, keepdims=True) + EPS)
    return (y * g.astype(F32)).astype(x.dtype)


def swiglu(x, w1, w3, w2):
    return (jax.nn.silu(x @ w1) * (x @ w3)) @ w2


def t5_bucket(dist):
    dist = jnp.maximum(dist, 0)
    max_exact = NUM_BUCKETS // 2
    d_f = jnp.maximum(dist, 1).astype(F32)
    large = max_exact + (jnp.log(d_f / max_exact) / math.log(MAX_DISTANCE / max_exact)
                         * (NUM_BUCKETS - max_exact)).astype(jnp.int32)
    large = jnp.minimum(large, NUM_BUCKETS - 1)
    return jnp.where(dist < max_exact, dist, large)


def rel_bias(table, dist):
    return table.astype(F32)[t5_bucket(dist)]


def local_dist():
    return jnp.arange(BLOCK)[:, None] + BLOCK - jnp.arange(2 * BLOCK)[None, :]


def banded_attention(q, k, v, bias, max_dist):
    n, L, H, dh = q.shape
    hk = k.shape[2]
    g = H // hk
    nb = -(-L // BLOCK)
    lp = nb * BLOCK
    pad = lp - L
    qb = jnp.pad(q, ((0, 0), (0, pad), (0, 0), (0, 0))).reshape(n, nb, BLOCK, hk, g, dh)

    def windows(t):
        tp = jnp.pad(t, ((0, 0), (BLOCK, pad), (0, 0), (0, 0))).reshape(n, nb + 1, BLOCK, hk, dh)
        return jnp.concatenate([tp[:, :-1], tp[:, 1:]], axis=2)

    kw, vw = windows(k), windows(v)
    s = jnp.einsum('nbqhgd,nbshd->nbhgqs', qb, kw, preferred_element_type=F32) * (dh ** -0.5)
    s = s + bias.reshape(hk, g, BLOCK, 2 * BLOCK)[None, None]
    loc = local_dist()
    key_abs = jnp.arange(nb)[:, None, None] * BLOCK + jnp.arange(2 * BLOCK)[None, None, :] - BLOCK
    mask = (loc >= 0)[None] & (loc <= max_dist)[None] & (key_abs >= 0)
    s = jnp.where(mask[None, :, None, None], s, -jnp.inf)
    m = jnp.max(s, axis=-1, keepdims=True)
    p = jnp.exp(s - m)
    den = jnp.sum(p, axis=-1)
    o = jnp.einsum('nbhgqs,nbshd->nbqhgd', p, vw.astype(F32))
    o = o / jnp.transpose(den, (0, 1, 4, 2, 3))[..., None]
    lse = jnp.transpose(m[..., 0] + jnp.log(den), (0, 1, 4, 2, 3))
    o = o.reshape(n, lp, H, dh)[:, :L]
    lse = lse.reshape(n, lp, H)[:, :L]
    return o, lse


def dilated_mixture(q, k, v, table):
    bn, S, H, dh = q.shape
    outs, lses = [], []
    for window, dil in A_BRANCHES:
        ls = S // dil

        def fold(t):
            return t.reshape(bn, ls, dil, H, dh).transpose(0, 2, 1, 3, 4).reshape(bn * dil, ls, H, dh)

        bias = jnp.moveaxis(rel_bias(table, dil * local_dist()), -1, 0)
        o, lse = banded_attention(fold(q), fold(k), fold(v), bias, window // dil)
        outs.append(o.reshape(bn, dil, ls, H, dh).transpose(0, 2, 1, 3, 4).reshape(bn, S, H, dh))
        lses.append(lse.reshape(bn, dil, ls, H).transpose(0, 2, 1, 3).reshape(bn, S, H))
    wts = jax.nn.softmax(jnp.stack(lses), axis=0)
    return jnp.einsum('rbsh,rbshd->bshd', wts, jnp.stack(outs))


def dsa_attention(q, k, v, q_idx, k_idx, w_idx, table, topk):
    bn, S, H, dh = q.shape
    nb = S // BLOCK
    idx_scale = (IDX_DIM ** -0.5) * (IDX_HEADS ** -0.5)
    spos = jnp.arange(S)

    def to_blocks(t):
        return jnp.swapaxes(t.reshape((bn, nb, BLOCK) + t.shape[2:]), 0, 1)

    def one_block(args):
        qb, qib, wb, t0 = args
        tpos = t0 + jnp.arange(BLOCK)
        sc = jax.nn.relu(jnp.einsum('bqhd,bsd->bqhs', qib, k_idx, preferred_element_type=F32))
        score = jnp.einsum('bqhs,bqh->bqs', sc, wb.astype(F32)) * idx_scale
        score = jnp.where((spos[None, :] <= tpos[:, None])[None], score, -jnp.inf)
        _, idx = lax.top_k(score, topk)
        ks = jax.vmap(lambda kk, ii: kk[ii])(k, idx)
        vs = jax.vmap(lambda vv, ii: vv[ii])(v, idx)
        dist = tpos[None, :, None] - idx
        logits = jnp.einsum('bqhd,bqkhd->bqhk', qb, ks, preferred_element_type=F32) * (dh ** -0.5)
        logits = logits + jnp.moveaxis(rel_bias(table, dist), -1, 2)
        logits = jnp.where((dist >= 0)[:, :, None, :], logits, -jnp.inf)
        p = jax.nn.softmax(logits, axis=-1)
        return jnp.einsum('bqhk,bqkhd->bqhd', p, vs.astype(F32))

    t0s = jnp.arange(nb, dtype=jnp.int32) * BLOCK
    out = lax.map(one_block, (to_blocks(q), to_blocks(q_idx), to_blocks(w_idx), t0s))
    return jnp.swapaxes(out, 0, 1).reshape(bn, S, H, dh)


def hybrid_ab_mixer(u, table, w_in, cq_g, wq_b, wq_idx, w_out):
    bn, S, _ = u.shape
    proj = u @ w_in
    qa, ka, va, cq, kb, vb, k_idx, w_idx = jnp.split(proj, _offsets(EVEN_SIZES), axis=-1)
    hs = (bn, S, A_HEADS, HEAD_DIM)
    o_a = dilated_mixture(qa.reshape(hs), ka.reshape(hs), va.reshape(hs), table[:, :A_HEADS])
    cq = rmsnorm(cq, cq_g)
    hb = (bn, S, B_HEADS, HEAD_DIM)
    qb = (cq @ wq_b).reshape(hb)
    q_idx = (cq @ wq_idx).reshape(bn, S, IDX_HEADS, IDX_DIM)
    topk = min(TOPK_MAX, S // 4)
    o_b = dsa_attention(qb, kb.reshape(hb), vb.reshape(hb), q_idx, k_idx, w_idx,
                        table[:, A_HEADS:], topk)
    o = jnp.concatenate([o_a.reshape(bn, S, A_W), o_b.reshape(bn, S, B_W)], axis=-1)
    return o.astype(u.dtype) @ w_out


def swa_sink_mixer(u, table, w_in, sinks, w_out):
    bn, S, _ = u.shape
    q, k, v = jnp.split(u @ w_in, _offsets(ODD_SIZES), axis=-1)
    q = q.reshape(bn, S, C_HEADS, HEAD_DIM)
    k = k.reshape(bn, S, C_KV_HEADS, HEAD_DIM)
    v = v.reshape(bn, S, C_KV_HEADS, HEAD_DIM)
    bias = jnp.moveaxis(rel_bias(table, local_dist()), -1, 0)
    o, lse = banded_attention(q, k, v, bias, C_WINDOW - 1)
    o = o * jax.nn.sigmoid(lse - sinks.astype(F32))[..., None]
    return o.reshape(bn, S, C_HEADS * HEAD_DIM).astype(u.dtype) @ w_out


def setup_inputs(seed: int = 0) -> dict:
    key = jax.random.key(seed)
    ks = jax.random.split(key, 20)
    nrm = lambda k, shape, scale: jax.random.normal(k, shape, F32) * scale
    return {
        "x": nrm(ks[0], (BATCH, SEQ, D_MODEL), 1.0),
        "norm_g": 1.0 + nrm(ks[1], (DEPTH, 3, D_MODEL), 0.02),
        "final_g": 1.0 + nrm(ks[2], (D_MODEL,), 0.02),
        "rel_bias_table": nrm(ks[3], (NUM_BUCKETS, N_HEADS), 0.2),
        "ffn_w1": nrm(ks[4], (DEPTH, 2, D_MODEL, D_FF), D_MODEL ** -0.5),
        "ffn_w3": nrm(ks[5], (DEPTH, 2, D_MODEL, D_FF), D_MODEL ** -0.5),
        "ffn_w2": nrm(ks[6], (DEPTH, 2, D_FF, D_MODEL), D_FF ** -0.5),
        "hyb_w_in": nrm(ks[7], (N_EVEN, D_MODEL, EVEN_IN), D_MODEL ** -0.5),
        "hyb_cq_g": 1.0 + nrm(ks[8], (N_EVEN, B_Q_RANK), 0.02),
        "hyb_wq_b": nrm(ks[9], (N_EVEN, B_Q_RANK, B_W), B_Q_RANK ** -0.5),
        "hyb_wq_idx": nrm(ks[10], (N_EVEN, B_Q_RANK, IDX_HEADS * IDX_DIM), B_Q_RANK ** -0.5),
        "hyb_w_out": nrm(ks[11], (N_EVEN, A_W + B_W, D_MODEL), (A_W + B_W) ** -0.5),
        "swa_w_in": nrm(ks[12], (N_ODD, D_MODEL, ODD_IN), D_MODEL ** -0.5),
        "swa_sinks": nrm(ks[13], (N_ODD, C_HEADS), 1.0),
        "swa_w_out": nrm(ks[14], (N_ODD, C_HEADS * HEAD_DIM, D_MODEL), (C_HEADS * HEAD_DIM) ** -0.5),
    }


def reference(x, norm_g, final_g, rel_bias_table, ffn_w1, ffn_w3, ffn_w2, hyb_w_in, hyb_cq_g,
              hyb_wq_b, hyb_wq_idx, hyb_w_out, swa_w_in, swa_sinks, swa_w_out):
    h = x
    for layer in range(DEPTH):
        g = norm_g[layer]
        h = h + 0.5 * swiglu(rmsnorm(h, g[0]), ffn_w1[layer, 0], ffn_w3[layer, 0], ffn_w2[layer, 0])
        u = rmsnorm(h, g[1])
        i = layer // 2
        if layer % 2 == 0:
            mix = hybrid_ab_mixer(u, rel_bias_table, hyb_w_in[i], hyb_cq_g[i], hyb_wq_b[i],
                                  hyb_wq_idx[i], hyb_w_out[i])
        else:
            mix = swa_sink_mixer(u, rel_bias_table, swa_w_in[i], swa_sinks[i], swa_w_out[i])
        h = h + mix
        h = h + 0.5 * swiglu(rmsnorm(h, g[2]), ffn_w1[layer, 1], ffn_w3[layer, 1], ffn_w2[layer, 1])
    return rmsnorm(h, final_g)
```

```cpp
#include <hip/hip_runtime.h>
#include <cstdio>
#include <cstdint>

#define LAS __attribute__((address_space(3)))
#define GAS __attribute__((address_space(1)))
typedef _Float16 h16;
typedef _Float16 h16x8 __attribute__((ext_vector_type(8)));
typedef _Float16 h16x4 __attribute__((ext_vector_type(4)));
typedef _Float16 h16x2 __attribute__((ext_vector_type(2)));
typedef float f32x2 __attribute__((ext_vector_type(2)));
typedef float f32x4 __attribute__((ext_vector_type(4)));
typedef float f32x16 __attribute__((ext_vector_type(16)));
typedef unsigned u32x2 __attribute__((ext_vector_type(2)));
typedef unsigned u32x4 __attribute__((ext_vector_type(4)));
typedef short v4i16_t __attribute__((ext_vector_type(4)));
typedef GAS unsigned gu32;

#ifndef MK_PER_PHASE
#define MK_PER_PHASE 0
#endif
#ifndef MK_ONLY
#define MK_ONLY 0xFFFF
#endif
#ifndef MK_SKIP
#define MK_SKIP 0
#endif

constexpr int NB = 16, SEQ = 2048, DM = 1024, FF = 2816, M = NB * SEQ;
constexpr int EIN = 2856, EINP = 3072, OIN = 1280, QBW = 768;
constexpr int E_QA = 0, E_KA = 512, E_VA = 1024, E_CQ = 1536, E_KB = 1792, E_VB = 2304, E_KI = 2816, E_WI = 2848;
constexpr int O_Q = 0, O_K = 1024, O_V = 1152;
constexpr float EPS = 1e-6f;
constexpr float LOG2E = 1.4426950408889634f;
constexpr float QSCALE2 = 0.125f * LOG2E;
constexpr int LUTP = 2112;

constexpr size_t MiB = 1u << 20;
constexpr size_t WS_CTL = 0, CTL_ZERO_BYTES = 2 * MiB;
constexpr size_t WS_SS = 1 * MiB;
constexpr size_t WS_LUT = 2 * MiB;
constexpr size_t WS_LSE = 3 * MiB;
constexpr size_t WS_W = 4 * MiB;
constexpr size_t W13_BYTES = (size_t)2 * FF * DM * 2, W2_BYTES = (size_t)DM * FF * 2;
constexpr size_t WO_W13 = 0, WO_W2 = WO_W13 + 4 * W13_BYTES, WO_WINE = WO_W2 + 4 * W2_BYTES, WO_WQ = WO_WINE + (size_t)EINP * DM * 2,
                 WO_WOUTE = WO_WQ + (size_t)QBW * 256 * 2, WO_WINO = WO_WOUTE + (size_t)DM * DM * 2, WO_WOUTO = WO_WINO + (size_t)OIN * DM * 2, WO_END = WO_WOUTO + (size_t)DM * DM * 2;
static_assert(WO_END <= 80 * MiB, "weights fit");
constexpr size_t WS_XN = 84 * MiB, WS_BIG = 148 * MiB, WS_O = 340 * MiB, WS_QB = 404 * MiB, WS_BM = 452 * MiB, WS_END = 460 * MiB;
static_assert(WS_XN + (size_t)M * DM * 2 <= WS_BIG && WS_BIG + (size_t)M * EINP * 2 <= WS_O && WS_O + (size_t)M * DM * 2 <= WS_QB && WS_QB + (size_t)M * QBW * 2 <= WS_BM && WS_BM + (size_t)M * 64 * 4 <= WS_END, "ws map");
constexpr int CW_TMO = 0, CW_BAR = 4096;

constexpr int LDS_SCR = 151552;
constexpr int LDSCTL_OFF = LDS_SCR, MISC_OFF = LDSCTL_OFF + 320;
constexpr int LDS_BYTES = 155648;
constexpr int NWAVES = 8, NTHREADS = 512;

#define RLX_AGENT __ATOMIC_RELAXED, __HIP_MEMORY_SCOPE_AGENT
#define LDS_WAIT() asm volatile("s_waitcnt lgkmcnt(0)" ::: "memory")
#define VM_WAIT() asm volatile("s_waitcnt vmcnt(0)" ::: "memory")
__device__ __forceinline__ unsigned pkh(float lo, float hi) { f32x2 v = {lo, hi}; h16x2 h = __builtin_convertvector(v, h16x2); return __builtin_bit_cast(unsigned, h); }
__device__ __forceinline__ float ex2(float x) { return __builtin_amdgcn_exp2f(x); }
__device__ __forceinline__ float xhalf(float v) { return __shfl_xor(v, 32); }
__device__ __forceinline__ int crow_c(int r) { return (r & 3) + 8 * (r >> 2); }

namespace pg8 {
constexpr int BM = 256, BK = 64, HALF = 128, HTB = HALF * BK * 2, STAGE_BYTES = 8 * HTB, NXCD = 8, WGM = 8;
__host__ __device__ __forceinline__ int lds_byte(int r, int c) { const int st = (r >> 4) * 2 + (c >> 5), rr = r & 15, cc = c & 31, ob = rr * 64 + cc * 2; return st * 1024 + (ob ^ (((ob >> 9) & 1) << 5)); }
__host__ __device__ __forceinline__ void stage_rc(int b, int& R, int& C) { const int st = b / 1024, sb = b % 1024, swz = sb ^ (((sb >> 9) & 1) << 5); R = (st >> 1) * 16 + swz / 64; C = (st & 1) * 32 + (swz % 64) / 2; }
__host__ __device__ __forceinline__ int perm32(int rho) { const int n = rho >> 4, i = rho & 15; return 8 * (i >> 2) + 4 * n + (i & 3); }
struct Unit { int pm, pn; };
struct Gemm { const h16* A; const h16* Bt; int lda, ldb, K; };
struct StaticOrder {
    int nM, nN, nwg, G, c;
    __device__ void init(int Mr, int N, int G_, int c_) { nM = Mr / BM; nN = N / BM; nwg = nM * nN; G = G_; c = c_; }
    __device__ bool next(int i, Unit& u) const {
        const long L = (long)i * G + c; if (L >= nwg) return false;
        int wgid = (int)L; { const int q = nwg / NXCD, r = nwg % NXCD, xcd = wgid % NXCD, off = wgid / NXCD; wgid = (xcd < r ? xcd * (q + 1) : r * (q + 1) + (xcd - r) * q) + off; }
        const int nig = WGM * nN, gid = wgid / nig, fm = gid * WGM, gsz = (nM - fm) < WGM ? (nM - fm) : WGM;
        u.pm = fm + ((wgid % nig) % gsz); u.pn = (wgid % nig) / gsz; return true;
    }
};

struct EpiSwiGLU {
    static constexpr bool PERM = true;
    h16* O; int ldc; const float* ss;
    __device__ __forceinline__ void operator()(const f32x4 (&acc)[2][2][4][2], const Unit& u, int wr, int wc, int fr, int fq) const {
        const int row0 = u.pm * BM + wr * 64 + fr, col0 = u.pn * HALF + wc * 32 + 8 * fq;
#pragma unroll
        for (int ai = 0; ai < 2; ++ai)
#pragma unroll
            for (int m = 0; m < 4; ++m) {
                const int row = row0 + ai * HALF + m * 16;
                const float rinv = __builtin_amdgcn_rsqf(ss[row] * (1.0f / DM) + EPS);
                float o[8];
#pragma unroll
                for (int n = 0; n < 2; ++n)
#pragma unroll
                    for (int e = 0; e < 4; ++e) {
                        const float a = acc[ai][0][m][n][e] * rinv, b = acc[ai][1][m][n][e] * rinv;
                        o[4 * n + e] = a * b * __builtin_amdgcn_rcpf(1.0f + ex2(-a * LOG2E));
                    }
                u32x4 w; w.x = pkh(o[0], o[1]); w.y = pkh(o[2], o[3]); w.z = pkh(o[4], o[5]); w.w = pkh(o[6], o[7]);
                *(u32x4*)(O + (size_t)row * ldc + col0) = w;
            }
    }
};
struct EpiResid {
    static constexpr bool PERM = false;
    const float* Hin; float* Hout; h16* XN; float* ssout; float cmul;
    __device__ __forceinline__ void operator()(const f32x4 (&acc)[2][2][4][2], const Unit& u, int wr, int wc, int fr, int fq) const {
        const int row0 = u.pm * BM + wr * 64 + fr, col0 = u.pn * BM + wc * 32 + 4 * fq;
#pragma unroll
        for (int ai = 0; ai < 2; ++ai)
#pragma unroll
            for (int m = 0; m < 4; ++m) {
                const int row = row0 + ai * HALF + m * 16; const size_t off = (size_t)row * DM + col0; float s = 0.f;
#pragma unroll
                for (int bj = 0; bj < 2; ++bj)
#pragma unroll
                    for (int n = 0; n < 2; ++n) {
                        const f32x4 hin = *(const f32x4*)(Hin + off + bj * HALF + n * 16);
                        const f32x4 hn = hin + acc[ai][bj][m][n] * cmul;
                        *(f32x4*)(Hout + off + bj * HALF + n * 16) = hn;
                        u32x2 w; w.x = pkh(hn[0], hn[1]); w.y = pkh(hn[2], hn[3]);
                        *(u32x2*)(XN + off + bj * HALF + n * 16) = w;
                        s += (hn[0] * hn[0] + hn[1] * hn[1]) + (hn[2] * hn[2] + hn[3] * hn[3]);
                    }
                s += __shfl_xor(s, 16); s += __shfl_xor(s, 32);
                if (fq == 0) (void)__hip_atomic_fetch_add(ssout + row, s, RLX_AGENT);
                asm volatile("" ::: "memory");
            }
    }
};
struct EpiH16 {
    static constexpr bool PERM = true;
    h16* O; int ldc; const float* ss; float* sscq; int cq_pn;
    __device__ __forceinline__ void operator()(const f32x4 (&acc)[2][2][4][2], const Unit& u, int wr, int wc, int fr, int fq) const {
        const int row0 = u.pm * BM + wr * 64 + fr, col0 = u.pn * BM + wc * 32 + 8 * fq;
        const bool docq = (sscq != nullptr) && (u.pn == cq_pn);
#pragma unroll
        for (int ai = 0; ai < 2; ++ai)
#pragma unroll
            for (int m = 0; m < 4; ++m) {
                const int row = row0 + ai * HALF + m * 16;
                const float rinv = ss ? __builtin_amdgcn_rsqf(ss[row] * (1.0f / DM) + EPS) : 1.0f;
                float s = 0.f;
#pragma unroll
                for (int bj = 0; bj < 2; ++bj) {
                    const f32x4 v0 = acc[ai][bj][m][0] * rinv, v1 = acc[ai][bj][m][1] * rinv;
                    u32x4 w; w.x = pkh(v0[0], v0[1]); w.y = pkh(v0[2], v0[3]); w.z = pkh(v1[0], v1[1]); w.w = pkh(v1[2], v1[3]);
                    *(u32x4*)(O + (size_t)row * ldc + col0 + bj * HALF) = w;
                    s += (v0[0] * v0[0] + v0[1] * v0[1]) + (v0[2] * v0[2] + v0[3] * v0[3]) + (v1[0] * v1[0] + v1[1] * v1[1]) + (v1[2] * v1[2] + v1[3] * v1[3]);
                }
                if (docq) { s += __shfl_xor(s, 16); s += __shfl_xor(s, 32); if (fq == 0) (void)__hip_atomic_fetch_add(sscq + row, s, RLX_AGENT); }
            }
    }
};

template <class Epi, bool ALIGN_EPI>
__device__ __forceinline__ void gemm_phase(LAS unsigned char* lds, const int tid, const Gemm g, const StaticOrder& S, const Epi& E) {
    const int wid = __builtin_amdgcn_readfirstlane(tid >> 6), lane = tid & 63, wr = wid >> 2, wc = wid & 3, fr = lane & 15, fq = lane >> 4;
    const int K = g.K, nt = K / BK;
    unsigned voffA[2], voffB[2];
#pragma unroll
    for (int i = 0; i < 2; ++i) { int R, C; stage_rc(tid * 16 + i * 8192, R, C); const int Rb = Epi::PERM ? ((R & ~31) + perm32(R & 31)) : R;
        voffA[i] = (unsigned)(R * g.lda + C) * 2u; voffB[i] = (unsigned)(Rb * g.ldb + C) * 2u; }
    const size_t kstep = (size_t)(BK * 2);
    const size_t hstepA = (size_t)HALF * g.lda * 2, hstepB = (size_t)HALF * g.ldb * 2;
    const size_t tstepA = 2 * hstepA, tstepB = 2 * hstepB;
    const unsigned ldsw = (unsigned)wid * 1024u;
    const int aoff = lds_byte(wr * 64 + fr, fq * 8), boff = lds_byte(wc * 32 + fr, fq * 8);
#define PG8_SA(b, h) (((b) * 2 + (h)) * HTB)
#define PG8_SB(b, h) ((4 + (b) * 2 + (h)) * HTB)
#define PG8_STAGE(bufoff, gbase, voff) do { _Pragma("unroll") for (int _i = 0; _i < 2; ++_i) \
        __builtin_amdgcn_global_load_lds((const unsigned*)((const char*)(gbase) + (voff)[_i]), (LAS unsigned*)(lds + (bufoff) + ldsw + _i * 8192), 16, 0, 0); } while (0)
#define PG8_LDA(dst, b, h) do { _Pragma("unroll") for (int m = 0; m < 4; ++m) _Pragma("unroll") for (int k = 0; k < 2; ++k) dst[m][k] = *(const LAS h16x8*)(lds + PG8_SA(b, h) + aoff + m * 2048 + k * 1024); } while (0)
#define PG8_LDB(dst, b, h) do { _Pragma("unroll") for (int n = 0; n < 2; ++n) _Pragma("unroll") for (int k = 0; k < 2; ++k) dst[n][k] = *(const LAS h16x8*)(lds + PG8_SB(b, h) + boff + n * 2048 + k * 1024); } while (0)
#define PG8_MMA(ai, bj, At, Bt) do { __builtin_amdgcn_s_setprio(1); _Pragma("unroll") for (int m = 0; m < 4; ++m) _Pragma("unroll") for (int n = 0; n < 2; ++n) _Pragma("unroll") for (int k = 0; k < 2; ++k) \
        acc[ai][bj][m][n] = __builtin_amdgcn_mfma_f32_16x16x32_f16(Bt[n][k], At[m][k], acc[ai][bj][m][n], 0, 0, 0); __builtin_amdgcn_s_setprio(0); } while (0)
#define PG8_WAIT_V(n) asm volatile("s_waitcnt vmcnt(" #n ")" ::: "memory")
#define PG8_WAIT_L(n) asm volatile("s_waitcnt lgkmcnt(" #n ")" ::: "memory")
#define PG8_BAR __builtin_amdgcn_s_barrier()
#define PG8_SCHED __builtin_amdgcn_sched_barrier(0)
    Unit cur, nxt; int ui = 0;
    if (!S.next(0, cur)) return;
    f32x4 acc[2][2][4][2];
#pragma unroll
    for (int a = 0; a < 2; ++a)
#pragma unroll
        for (int b = 0; b < 2; ++b)
#pragma unroll
            for (int m = 0; m < 4; ++m)
#pragma unroll
                for (int n = 0; n < 2; ++n) acc[a][b][m][n] = (f32x4){0.f, 0.f, 0.f, 0.f};
    h16x8 At[4][2], B0[2][2], B1[2][2];
    const char* cA = (const char*)g.A + (size_t)cur.pm * tstepA; const char* cB = (const char*)g.Bt + (size_t)cur.pn * tstepB;
    PG8_STAGE(PG8_SB(0, 0), cB, voffB); PG8_STAGE(PG8_SB(0, 1), cB + hstepB, voffB); PG8_STAGE(PG8_SA(0, 0), cA, voffA); PG8_STAGE(PG8_SA(0, 1), cA + hstepA, voffA);
    if (wr == 1) PG8_BAR;
    PG8_WAIT_V(2); PG8_BAR;
    PG8_STAGE(PG8_SB(1, 0), cB + kstep, voffB); PG8_STAGE(PG8_SA(1, 0), cA + kstep, voffA); PG8_STAGE(PG8_SB(1, 1), cB + hstepB + kstep, voffB);
    PG8_WAIT_V(6); PG8_BAR;
    for (;;) {
        const bool has_next = S.next(ui + 1, nxt);
        const char* nA = has_next ? (const char*)g.A + (size_t)nxt.pm * tstepA : cA; const char* nB = has_next ? (const char*)g.Bt + (size_t)nxt.pn * tstepB : cB;
        for (int t = 0; t < nt; t += 2) {
            const bool last = (t == nt - 2);
            const char* a1 = cA + (size_t)(t + 1) * kstep;
            const char* a2 = last ? nA : cA + (size_t)(t + 2) * kstep; const char* b2 = last ? nB : cB + (size_t)(t + 2) * kstep;
            const char* a3 = a2 + kstep; const char* b3 = b2 + kstep;
            PG8_LDB(B0, 0, 0); PG8_LDB(B1, 0, 1); PG8_SCHED; PG8_LDA(At, 0, 0); PG8_STAGE(PG8_SA(1, 1), a1 + hstepA, voffA);
            PG8_WAIT_V(8); PG8_WAIT_L(0); PG8_BAR; PG8_MMA(0, 0, At, B0); PG8_MMA(0, 1, At, B1); PG8_BAR; PG8_SCHED;
            PG8_LDA(At, 0, 1); PG8_STAGE(PG8_SB(0, 0), b2, voffB); PG8_STAGE(PG8_SB(0, 1), b2 + hstepB, voffB); PG8_STAGE(PG8_SA(0, 0), a2, voffA);
            PG8_WAIT_V(8); PG8_WAIT_L(0); PG8_BAR; PG8_MMA(1, 0, At, B0); PG8_MMA(1, 1, At, B1); PG8_BAR; PG8_SCHED;
            PG8_LDB(B0, 1, 0); PG8_LDB(B1, 1, 1); PG8_SCHED; PG8_LDA(At, 1, 0); PG8_STAGE(PG8_SA(0, 1), a2 + hstepA, voffA);
            PG8_WAIT_V(8); PG8_WAIT_L(0); PG8_BAR; PG8_MMA(0, 0, At, B0); PG8_MMA(0, 1, At, B1); PG8_BAR; PG8_SCHED;
            PG8_LDA(At, 1, 1); PG8_STAGE(PG8_SB(1, 0), b3, voffB); PG8_STAGE(PG8_SB(1, 1), b3 + hstepB, voffB); PG8_STAGE(PG8_SA(1, 0), a3, voffA);
            PG8_WAIT_V(8); PG8_WAIT_L(0); PG8_BAR; PG8_MMA(1, 0, At, B0); PG8_MMA(1, 1, At, B1); PG8_BAR; PG8_SCHED;
        }
        if constexpr (ALIGN_EPI) { if (wr == 0) PG8_BAR; }
        E(acc, cur, wr, wc, fr, fq);
        if (!has_next) break;
#pragma unroll
        for (int a = 0; a < 2; ++a)
#pragma unroll
            for (int b = 0; b < 2; ++b)
#pragma unroll
                for (int m = 0; m < 4; ++m)
#pragma unroll
                    for (int n = 0; n < 2; ++n) acc[a][b][m][n] = (f32x4){0.f, 0.f, 0.f, 0.f};
        cur = nxt; cA = nA; cB = nB; ++ui;
        if constexpr (ALIGN_EPI) { if (wr == 1) PG8_BAR; }
    }
    PG8_WAIT_V(0);
    if constexpr (!ALIGN_EPI) { if (wr == 0) PG8_BAR; }
    PG8_BAR;
#undef PG8_SA
#undef PG8_SB
#undef PG8_STAGE
#undef PG8_LDA
#undef PG8_LDB
#undef PG8_MMA
#undef PG8_WAIT_V
#undef PG8_WAIT_L
#undef PG8_BAR
#undef PG8_SCHED
}
}

#define XB_TMO      128
#define XB_XCNT(j)  (256  + 64 * (j))
#define XB_XSUB(j)  (1280 + 64 * (j))
#define XB_XGEN(j)  (2304 + 64 * (j))
#define XB_TOP      3328
#define XB_TOPGEN   3392
#define XCD_BAR_WORDS 3456
#define XB_SPIN_CAP (1u << 18)
__device__ __forceinline__ unsigned xb_ld(unsigned* p)              { return __hip_atomic_load(p, __ATOMIC_RELAXED, __HIP_MEMORY_SCOPE_AGENT); }
__device__ __forceinline__ unsigned xb_add(unsigned* p, unsigned v) { return __hip_atomic_fetch_add(p, v, __ATOMIC_RELAXED, __HIP_MEMORY_SCOPE_AGENT); }
__device__ __forceinline__ unsigned xb_xcc_id() { return (unsigned)__builtin_amdgcn_s_getreg((3 << 11) | 20) & 0xFu; }
#define XB_SPIN(cond, bar) do { unsigned _sp = 0; while (cond) { __builtin_amdgcn_s_sleep(1); \
    if ((++_sp & 255u) == 0u) { if (xb_ld(&(bar)[XB_TMO])) break; if (_sp > XB_SPIN_CAP) { atomicAdd(&(bar)[XB_TMO], 1u); break; } } } } while (0)
struct XcdBarrier { unsigned* bar; unsigned x; volatile LAS unsigned* st; };
__device__ __forceinline__ XcdBarrier xcd_barrier_post(unsigned* bar, volatile LAS unsigned* st) {
    XcdBarrier b; b.bar = bar; b.x = xb_xcc_id(); b.st = st;
    if (threadIdx.x == 0) (void)xb_add(&bar[XB_XCNT(b.x)], 1u);
    return b;
}
__device__ __forceinline__ void xcd_barrier_complete(unsigned* bar, unsigned x, unsigned& nloc, unsigned& nx) {
    const unsigned G = gridDim.x * gridDim.y * gridDim.z;
    unsigned sum, cnt, mine, sp = 0u;
    for (;;) {
        sum = 0u; cnt = 0u; mine = 0u;
#pragma unroll
        for (unsigned j = 0; j < 16; ++j) { const unsigned c = xb_ld(&bar[XB_XCNT(j)]); sum += c; cnt += (c > 0u) ? 1u : 0u; mine = (j == x) ? c : mine; }
        if (sum == G) break;
        __builtin_amdgcn_s_sleep(1);
        if ((++sp & 255u) == 0u) { if (xb_ld(&bar[XB_TMO])) break; if (sp > XB_SPIN_CAP) { atomicAdd(&bar[XB_TMO], 1u); break; } }
    }
    nloc = mine > 0u ? mine : 1u; nx = cnt > 0u ? cnt : 1u;
}
__device__ __forceinline__ void xcd_barrier(const XcdBarrier& b) {
    asm volatile("s_waitcnt vmcnt(0)" ::: "memory");
    __syncthreads();
    if (threadIdx.x == 0) {
        unsigned* bar = b.bar;
        __builtin_amdgcn_s_waitcnt(0);
        unsigned nloc = b.st[0], nx = b.st[1];
        if (nloc == 0u) { xcd_barrier_complete(bar, b.x, nloc, nx); b.st[0] = nloc; b.st[1] = nx; }
        const unsigned old = xb_add(&bar[XB_XSUB(b.x)], 1u);
        const unsigned gen = old / nloc;
        if (old + 1u == (gen + 1u) * nloc) {
            __builtin_amdgcn_fence(__ATOMIC_RELEASE, "agent");
            asm volatile("s_waitcnt vmcnt(0)" ::: "memory");
            const unsigned og = xb_add(&bar[XB_TOP], 1u);
            const unsigned tg = og / nx;
            if (og + 1u == (tg + 1u) * nx) xb_add(&bar[XB_TOPGEN], 1u);
            else XB_SPIN(xb_ld(&bar[XB_TOPGEN]) == tg, bar);
            __builtin_amdgcn_fence(__ATOMIC_ACQUIRE, "agent");
            xb_add(&bar[XB_XGEN(b.x)], 1u);
            asm volatile("s_waitcnt vmcnt(0)" ::: "memory");
        } else {
            XB_SPIN(xb_ld(&bar[XB_XGEN(b.x)]) == gen, bar);
            __builtin_amdgcn_fence(__ATOMIC_ACQUIRE, "agent");
            asm volatile("s_waitcnt vmcnt(0)" ::: "memory");
        }
    }
    __syncthreads();
}

struct Args {
    const float* x; const float* norm_g; const float* final_g; const float* table; const float* w1; const float* w3; const float* w2;
    const float* hyb_w_in; const float* hyb_cq_g; const float* hyb_wq_b; const float* hyb_wq_idx; const float* hyb_w_out;
    const float* swa_w_in; const float* swa_sinks; const float* swa_w_out;
    float* out; unsigned char* ws; int ph_lo, ph_hi;
};

__device__ __forceinline__ void tr_item(const float* src, int ldsrc, int col0, int ncols_valid, const float* gain, int K, int k0, h16* dst, LAS float* scr, int lane) {
    const int c = col0 + (lane & 31); const bool ok = c < ncols_valid;
#pragma unroll 8
    for (int i = 0; i < 32; ++i) { const int kk = 2 * i + (lane >> 5); float v = ok ? src[(size_t)(k0 + kk) * ldsrc + c] : 0.f; if (gain) v *= gain[k0 + kk]; scr[kk * 33 + (lane & 31)] = v; }
    LDS_WAIT(); asm volatile("" ::: "memory");
    const int ch = lane & 7;
#pragma unroll
    for (int j = 0; j < 4; ++j) { const int n = (lane >> 3) + 8 * j; const LAS float* s = scr + (8 * ch) * 33 + n;
        u32x4 o; o.x = pkh(s[0 * 33], s[1 * 33]); o.y = pkh(s[2 * 33], s[3 * 33]); o.z = pkh(s[4 * 33], s[5 * 33]); o.w = pkh(s[6 * 33], s[7 * 33]);
        *(u32x4*)(dst + (size_t)n * K + k0 + 8 * ch) = o; }
    LDS_WAIT(); asm volatile("" ::: "memory");
}
__device__ __forceinline__ int t5_bucket(int d) {
    if (d < 16) return d;
    int b = 16;
    b += (d >= 22) + (d >= 30) + (d >= 40) + (d >= 54) + (d >= 73) + (d >= 99) + (d >= 134) + (d >= 182) + (d >= 246) + (d >= 332) + (d >= 450) + (d >= 609) + (d >= 825) + (d >= 1117) + (d >= 1513);
    return b;
}
__device__ __forceinline__ void prologue(const Args& a, unsigned char* ws, LAS unsigned char* lds, int gw, int NGW, int wave, int lane) {
    LAS float* scr = (LAS float*)(lds + wave * 16384);
    h16* wb = (h16*)(ws + WS_W);
    constexpr int I13 = (DM / 64) * (2 * FF / 32);
    constexpr int I2 = (FF / 64) * (DM / 32);
    constexpr int IWE = (DM / 64) * (EINP / 32);
    constexpr int IWQ = (256 / 64) * (QBW / 32);
    constexpr int IWO = (DM / 64) * (DM / 32);
    constexpr int IWI = (DM / 64) * (OIN / 32);
    constexpr int NITEMS = 4 * I13 + 4 * I2 + IWE + IWQ + IWO + IWI + IWO;
    for (int it = gw; it < NITEMS; it += NGW) {
        int r = it;
        if (r < 4 * I13) { const int lj = r / I13; r -= lj * I13; const int l = lj >> 1, j = lj & 1; const int kb = r / 176, nb = r % 176, t = nb >> 3, wbk = nb & 7;
            const float* src = (wbk < 4 ? a.w1 : a.w3) + (size_t)lj * DM * FF; const int col0 = 128 * t + 32 * (wbk & 3);
            tr_item(src, FF, col0, FF, a.norm_g + (l * 3 + 2 * j) * DM, DM, 64 * kb, wb + (WO_W13 + lj * W13_BYTES) / 2 + (size_t)(32 * nb) * DM, scr, lane); continue; }
        r -= 4 * I13;
        if (r < 4 * I2) { const int lj = r / I2; r -= lj * I2; const int kb = r / 32, nb = r % 32;
            tr_item(a.w2 + (size_t)lj * FF * DM, DM, 32 * nb, DM, nullptr, FF, 64 * kb, wb + (WO_W2 + lj * W2_BYTES) / 2 + (size_t)(32 * nb) * FF, scr, lane); continue; }
        r -= 4 * I2;
        if (r < IWE) { const int kb = r / 96, nb = r % 96;
            tr_item(a.hyb_w_in, EIN, 32 * nb, EIN, a.norm_g + 1 * DM, DM, 64 * kb, wb + WO_WINE / 2 + (size_t)(32 * nb) * DM, scr, lane); continue; }
        r -= IWE;
        if (r < IWQ) { const int kb = r / 24, nb = r % 24;
            if (nb < 16) tr_item(a.hyb_wq_b, 512, 32 * nb, 512, a.hyb_cq_g, 256, 64 * kb, wb + WO_WQ / 2 + (size_t)(32 * nb) * 256, scr, lane);
            else tr_item(a.hyb_wq_idx, 256, 32 * (nb - 16), 256, a.hyb_cq_g, 256, 64 * kb, wb + WO_WQ / 2 + (size_t)(32 * nb) * 256, scr, lane);
            continue; }
        r -= IWQ;
        if (r < IWO) { const int kb = r / 32, nb = r % 32;
            tr_item(a.hyb_w_out, DM, 32 * nb, DM, nullptr, DM, 64 * kb, wb + WO_WOUTE / 2 + (size_t)(32 * nb) * DM, scr, lane); continue; }
        r -= IWO;
        if (r < IWI) { const int kb = r / 40, nb = r % 40;
            tr_item(a.swa_w_in, OIN, 32 * nb, OIN, a.norm_g + (3 + 1) * DM, DM, 64 * kb, wb + WO_WINO / 2 + (size_t)(32 * nb) * DM, scr, lane); continue; }
        r -= IWI;
        { const int kb = r / 32, nb = r % 32;
            tr_item(a.swa_w_out, DM, 32 * nb, DM, nullptr, DM, 64 * kb, wb + WO_WOUTO / 2 + (size_t)(32 * nb) * DM, scr, lane); }
    }
    { float* lut = (float*)(ws + WS_LUT);
      for (int i = gw * 64 + lane; i < 16 * LUTP; i += NGW * 64) { const int h = i / LUTP, d = i % LUTP; lut[i] = a.table[t5_bucket(d < 2048 ? d : 2047) * 16 + h] * LOG2E; } }
    { h16* XN = (h16*)(ws + WS_XN); float* ss0 = (float*)(ws + WS_SS);
      for (int m = gw; m < M; m += NGW) {
          const f32x4* xr = (const f32x4*)(a.x + (size_t)m * DM) + lane; float s = 0.f; u32x2* o8 = (u32x2*)(XN + (size_t)m * DM) + lane;
#pragma unroll
          for (int j = 0; j < 4; ++j) { const f32x4 v = xr[64 * j]; s += (v[0] * v[0] + v[1] * v[1]) + (v[2] * v[2] + v[3] * v[3]); u32x2 w; w.x = pkh(v[0], v[1]); w.y = pkh(v[2], v[3]); o8[64 * j] = w; }
#pragma unroll
          for (int o = 1; o < 64; o <<= 1) s += __shfl_xor(s, o);
          if (lane == 0) ss0[m] = s;
      } }
}

__device__ __forceinline__ h16x8 pack8(float a0, float a1, float a2, float a3, float a4, float a5, float a6, float a7) {
    u32x4 w; w.x = pkh(a0, a1); w.y = pkh(a2, a3); w.z = pkh(a4, a5); w.w = pkh(a6, a7); return __builtin_bit_cast(h16x8, w);
}
__device__ __forceinline__ h16x4 vtr(const LAS unsigned char* p) { return __builtin_bit_cast(h16x4, __builtin_amdgcn_ds_read_tr16_b64_v4i16((LAS v4i16_t*)p)); }
template <int NK> struct KVImg { static constexpr int KCH = NK * 16 + 16, KBYTES = 8 * KCH, VDH = NK * 64 + 64, VBYTES = 2 * VDH; };
template <int NK> __device__ __forceinline__ f32x16 qk_tile(const LAS unsigned char* Kimg, int kr0, const h16x8 (&qf)[4], int r32, int hi) {
    f32x16 acc = {};
    const LAS unsigned char* kp = Kimg + hi * KVImg<NK>::KCH + (kr0 + r32) * 16;
#pragma unroll
    for (int ks = 0; ks < 4; ++ks) { const h16x8 kf = *(const LAS h16x8*)(kp + 2 * ks * KVImg<NK>::KCH); acc = __builtin_amdgcn_mfma_f32_32x32x16_f16(kf, qf[ks], acc, 0, 0, 0); }
    return acc;
}
template <int NK> __device__ __forceinline__ void pv_tile(f32x16 (&o)[2], const LAS unsigned char* Vimg, int kr0, const f32x16& p, int lane, int hi) {
    const LAS unsigned char* vp = Vimg + (kr0 + 4 * hi + ((lane & 15) >> 2)) * 64 + ((lane >> 4) & 1) * 32 + (lane & 3) * 8;
#pragma unroll
    for (int s = 0; s < 2; ++s) {
        const h16x8 pf = pack8(p[8 * s + 0], p[8 * s + 1], p[8 * s + 2], p[8 * s + 3], p[8 * s + 4], p[8 * s + 5], p[8 * s + 6], p[8 * s + 7]);
#pragma unroll
        for (int d0 = 0; d0 < 2; ++d0) {
            const h16x4 lo = vtr(vp + d0 * KVImg<NK>::VDH + s * 1024), hv = vtr(vp + d0 * KVImg<NK>::VDH + s * 1024 + 512);
            const h16x8 vf = {lo[0], lo[1], lo[2], lo[3], hv[0], hv[1], hv[2], hv[3]};
            o[d0] = __builtin_amdgcn_mfma_f32_32x32x16_f16(vf, pf, o[d0], 0, 0, 0);
        }
    }
}
template <int NK> __device__ __forceinline__ void fill_kv(LAS unsigned char* Kimg, LAS unsigned char* Vimg, const h16* base, long grow0, int gstride, int ld, int kcol, int vcol, int r_lo, int r_hi, int tid, int nthr) {
    const int npieces = (r_hi - r_lo) * 8;
    for (int p = tid; p < npieces; p += nthr) {
        const int row = r_lo + (p >> 3), c = p & 7;
        const h16* g = base + (size_t)(grow0 + (long)row * gstride) * ld + c * 8;
        const u32x4 kv = *(const u32x4*)(g + kcol), vv = *(const u32x4*)(g + vcol);
        *(LAS u32x4*)(Kimg + c * KVImg<NK>::KCH + row * 16) = kv;
        *(LAS u32x4*)(Vimg + (c >> 2) * KVImg<NK>::VDH + row * 64 + (c & 3) * 16) = vv;
    }
}

struct BandTask {
    const h16* qrow;
    h16* orow;
    float* lsep;
    const float* lutg;
    int dil, maxd, mode; float sink2;
    int qsub; bool has_prev;
};
__device__ __forceinline__ void band_task(const BandTask& T, const LAS unsigned char* Kimg, const LAS unsigned char* Vimg, LAS float* lut, int lane) {
    const int r32 = lane & 31, hi = lane >> 5;
#pragma unroll
    for (int j = 0; j < 3; ++j) { const int idx = lane + 64 * j; const int rel = idx - 31; lut[idx] = (rel >= 0 && rel <= T.maxd) ? T.lutg[rel * T.dil] : -INFINITY; }
    h16x8 qf[4];
#pragma unroll
    for (int ks = 0; ks < 4; ++ks) qf[ks] = *(const h16x8*)(T.qrow + ks * 16 + hi * 8);
    LDS_WAIT(); asm volatile("" ::: "memory");
    const int laneb = r32 - 4 * hi + 4;
    f32x16 s[5];
    float mx = -INFINITY;
#pragma unroll
    for (int i = 0; i < 5; ++i) {
        const int kr0 = 32 * T.qsub + 32 * i;
        if (T.has_prev || kr0 >= 128) {
            const f32x16 acc = qk_tile<256>(Kimg, kr0, qf, r32, hi);
#pragma unroll
            for (int r = 0; r < 16; ++r) { const float v = acc[r] * QSCALE2 + lut[laneb + (128 - 32 * i) + (27 - crow_c(r))]; s[i][r] = v; mx = fmaxf(mx, v); }
        } else {
#pragma unroll
            for (int r = 0; r < 16; ++r) s[i][r] = -INFINITY;
        }
    }
    mx = fmaxf(mx, xhalf(mx));
    float l = 0.f;
#pragma unroll
    for (int i = 0; i < 5; ++i)
#pragma unroll
        for (int r = 0; r < 16; ++r) { const float p = ex2(s[i][r] - mx); s[i][r] = p; l += p; }
    l += xhalf(l);
    f32x16 o[2]; o[0] = f32x16{}; o[1] = f32x16{};
#pragma unroll
    for (int i = 0; i < 5; ++i) {
        const int kr0 = 32 * T.qsub + 32 * i;
        if (T.has_prev || kr0 >= 128) pv_tile<256>(o, Vimg, kr0, s[i], lane, hi);
    }
    const float inv = 1.0f / l;
    float lse = mx + __builtin_amdgcn_logf(l);
    float wc = inv, wo = 0.f;
    if (T.mode == 1 || T.mode == 2) {
        const float lo = *T.lsep; const float m2 = fmaxf(lo, lse); const float eo = ex2(lo - m2), ec = ex2(lse - m2); const float den = eo + ec;
        wo = eo / den; wc = inv * ec / den; lse = m2 + __builtin_amdgcn_logf(den);
    } else if (T.mode == 3) {
        wc = inv / (1.0f + ex2(T.sink2 - lse));
    }
#pragma unroll
    for (int d0 = 0; d0 < 2; ++d0)
#pragma unroll
        for (int g4 = 0; g4 < 4; ++g4) {
            h16* op = T.orow + 32 * d0 + 8 * g4 + 4 * hi;
            float v0 = o[d0][4 * g4 + 0] * wc, v1 = o[d0][4 * g4 + 1] * wc, v2 = o[d0][4 * g4 + 2] * wc, v3 = o[d0][4 * g4 + 3] * wc;
            if (T.mode == 1 || T.mode == 2) { const h16x4 ov = *(const h16x4*)op; v0 += wo * (float)ov[0]; v1 += wo * (float)ov[1]; v2 += wo * (float)ov[2]; v3 += wo * (float)ov[3]; }
            u32x2 w; w.x = pkh(v0, v1); w.y = pkh(v2, v3); *(u32x2*)op = w;
        }
    if ((T.mode == 0 || T.mode == 1) && hi == 0) *T.lsep = lse;
}

constexpr int BAND_K = 0, BAND_V = KVImg<256>::KBYTES, BAND_LUT = BAND_V + KVImg<256>::VBYTES, BAND_HALF = BAND_LUT + 4 * 768;
static_assert(2 * BAND_HALF <= LDS_SCR, "band LDS");

__device__ __forceinline__ void phase_band_A(const Args& a, unsigned char* ws, LAS unsigned char* lds, int vcu, int G, int tid, int wave, int lane, int dil, int mode) {
    const int half = wave >> 2, wq = wave & 3, th = tid & 255;
    LAS unsigned char* hb = lds + half * BAND_HALF;
    const h16* P = (const h16*)(ws + WS_BIG); h16* O = (h16*)(ws + WS_O); float* LSE = (float*)(ws + WS_LSE); const float* lutg = (const float*)(ws + WS_LUT);
    const int nblk = (SEQ / dil) / 128;
    for (int u = vcu; u < 1024; u += G) {
        const int sub = 2 * u + half;
        const int jb = sub % nblk; int t = sub / nblk; const int h = t & 7; t >>= 3; const int r = t % dil, b = t / dil;
        const long rowbase = (long)b * SEQ + r;
        const int w0 = 128 * (jb - 1);
        fill_kv<256>(hb + BAND_K, hb + BAND_V, P, rowbase + (long)w0 * dil, dil, EINP, E_KA + 64 * h, E_VA + 64 * h, jb > 0 ? 0 : 128, 256, th, 256);
        __syncthreads();
        const long qtok = rowbase + (long)(128 * jb + 32 * wq + (lane & 31)) * dil;
        BandTask T; T.qrow = P + (size_t)qtok * EINP + E_QA + 64 * h; T.orow = O + (size_t)qtok * DM + 64 * h; T.lsep = LSE + (size_t)qtok * 8 + h;
        T.lutg = lutg + h * LUTP; T.dil = dil; T.maxd = 128; T.mode = mode; T.sink2 = 0.f; T.qsub = wq; T.has_prev = jb > 0;
        band_task(T, hb + BAND_K, hb + BAND_V, (LAS float*)(hb + BAND_LUT + wq * 768), lane);
        __syncthreads();
    }
}
__device__ __forceinline__ void phase_band_C(const Args& a, unsigned char* ws, LAS unsigned char* lds, int vcu, int G, int tid, int wave, int lane) {
    const int half = wave >> 2, wq = wave & 3, th = tid & 255;
    LAS unsigned char* hb = lds + half * BAND_HALF;
    const h16* P = (const h16*)(ws + WS_BIG); h16* O = (h16*)(ws + WS_O); const float* lutg = (const float*)(ws + WS_LUT);
    for (int u = vcu; u < 256; u += G) {
        const int sub = 2 * u + half;
        const int jb = sub & 15, kvh = (sub >> 4) & 1, b = sub >> 5;
        const long rowbase = (long)b * SEQ;
        fill_kv<256>(hb + BAND_K, hb + BAND_V, P, rowbase + 128 * (jb - 1), 1, OIN, O_K + 64 * kvh, O_V + 64 * kvh, jb > 0 ? 0 : 128, 256, th, 256);
        __syncthreads();
        const long qtok = rowbase + 128 * jb + 32 * wq + (lane & 31);
        for (int j = 0; j < 8; ++j) {
            const int h = 8 * kvh + j;
            BandTask T; T.qrow = P + (size_t)qtok * OIN + O_Q + 64 * h; T.orow = O + (size_t)qtok * DM + 64 * h; T.lsep = nullptr;
            T.lutg = lutg + h * LUTP; T.dil = 1; T.maxd = 127; T.mode = 3; T.sink2 = a.swa_sinks[h] * LOG2E; T.qsub = wq; T.has_prev = jb > 0;
            band_task(T, hb + BAND_K, hb + BAND_V, (LAS float*)(hb + BAND_LUT + wq * 768), lane);
        }
        __syncthreads();
    }
}

constexpr int SC_PITCH = 2052;
static_assert(16 * SC_PITCH * 4 <= LDS_SCR, "score LDS");
__device__ __forceinline__ unsigned f2key(float f) { const unsigned u = __builtin_bit_cast(unsigned, f + 0.0f); return (u & 0x80000000u) ? ~u : (u | 0x80000000u); }
__device__ __forceinline__ void phase_select(const Args& a, unsigned char* ws, LAS unsigned char* lds, int vcu, int G, int tid, int wave, int lane) {
    const h16* P = (const h16*)(ws + WS_BIG); const h16* QB = (const h16*)(ws + WS_QB); unsigned* BMP = (unsigned*)(ws + WS_BM);
    LAS unsigned* sc = (LAS unsigned*)lds;
    const int q16 = lane & 15, g4 = lane >> 4;
    for (int i = 0; i < 8; ++i) {
        for (int uu = vcu; uu < 256; uu += G) {
            const int b = uu >> 4, j = uu & 15; const int qt = (i & 1) ? (32 * (i >> 1) + 31 - j) : (32 * (i >> 1) + j);
            const int t0 = 16 * qt; const long rowb = (long)b * SEQ;
            { h16x8 qi[8]; float wv[8];
              const h16* qrow = QB + (size_t)(rowb + t0 + q16) * QBW + 512 + 8 * g4;
#pragma unroll
              for (int h = 0; h < 8; ++h) qi[h] = *(const h16x8*)(qrow + 32 * h);
              { const h16x8 w8 = *(const h16x8*)(P + (size_t)(rowb + t0 + q16) * EINP + E_WI);
#pragma unroll
                for (int h = 0; h < 8; ++h) wv[h] = (float)w8[h]; }
              for (int kt = wave; kt <= qt; kt += 8) {
                  const h16x8 kf = *(const h16x8*)(P + (size_t)(rowb + 16 * kt + q16) * EINP + E_KI + 8 * g4);
                  f32x4 sacc = {0.f, 0.f, 0.f, 0.f};
#pragma unroll
                  for (int h = 0; h < 8; ++h) { const f32x4 z = {0.f, 0.f, 0.f, 0.f}; const f32x4 d = __builtin_amdgcn_mfma_f32_16x16x32_f16(kf, qi[h], z, 0, 0, 0);
#pragma unroll
                      for (int e = 0; e < 4; ++e) sacc[e] += wv[h] * fmaxf(d[e], 0.f); }
                  u32x4 kk; kk.x = f2key(sacc[0]); kk.y = f2key(sacc[1]); kk.z = f2key(sacc[2]); kk.w = f2key(sacc[3]);
                  *(LAS u32x4*)(sc + q16 * SC_PITCH + 16 * kt + 4 * g4) = kk;
              } }
            __syncthreads();
            for (int rr = 0; rr < 2; ++rr) {
                const int row = 2 * wave + rr; const int t = t0 + row;
                unsigned key[32];
#pragma unroll
                for (int jj = 0; jj < 8; ++jj) { const u32x4 v = *(const LAS u32x4*)(sc + row * SC_PITCH + 256 * jj + 4 * lane);
#pragma unroll
                    for (int e = 0; e < 4; ++e) { const int idx = 256 * jj + 4 * lane + e; key[4 * jj + e] = (idx <= t) ? v[e] : 0u; } }
                unsigned T = 1u; int Ilim = 4096; bool strict_only = false;
                if (t >= 256) {
                    T = 0u; bool exact = false;
                    for (int bit = 31; bit >= 0; --bit) {
                        const unsigned cand = T | (1u << bit); int cnt = 0;
#pragma unroll
                        for (int k = 0; k < 32; ++k) cnt += __popcll(__ballot(key[k] >= cand));
                        if (cnt >= 256) { T = cand; if (cnt == 256) { exact = true; break; } }
                    }
                    if (exact) { strict_only = true; }
                    else {
                        int cgt = 0;
#pragma unroll
                        for (int k = 0; k < 32; ++k) cgt += __popcll(__ballot(key[k] > T));
                        const int need = 256 - cgt; int I = 0;
                        for (int bit = 10; bit >= 0; --bit) {
                            const int cand = I | (1 << bit); int c = 0;
#pragma unroll
                            for (int k = 0; k < 32; ++k) { const int idx = 256 * (k >> 2) + 4 * lane + (k & 3); c += __popcll(__ballot(key[k] == T && idx < cand)); }
                            if (c < need) I = cand;
                        }
                        Ilim = I;
                    }
                } else { strict_only = true; T = 1u; }
                unsigned* bmrow = BMP + (size_t)(rowb + t) * 64;
#pragma unroll
                for (int jj = 0; jj < 8; ++jj) {
                    unsigned nib = 0u;
#pragma unroll
                    for (int e = 0; e < 4; ++e) { const int k = 4 * jj + e; const int idx = 256 * jj + 4 * lane + e;
                        const bool sel = strict_only ? (key[k] >= T) : (key[k] > T || (key[k] == T && idx <= Ilim)); nib |= (sel ? 1u : 0u) << e; }
                    unsigned v = nib << (4 * (lane & 7));
                    v |= __shfl_xor(v, 1); v |= __shfl_xor(v, 2); v |= __shfl_xor(v, 4);
                    if ((lane & 7) == 0) bmrow[8 * jj + (lane >> 3)] = v;
                }
            }
            __syncthreads();
        }
    }
}

constexpr int B2_K = 0, B2_V = 2 * KVImg<128>::KBYTES, B2_LUT = B2_V + 2 * KVImg<128>::VBYTES, B2_END = B2_LUT + 2080 * 4;
static_assert(B2_END <= LDS_SCR, "B2 LDS");
__device__ __forceinline__ void phase_dsa(const Args& a, unsigned char* ws, LAS unsigned char* lds, int vcu, int G, int tid, int wave, int lane) {
    const h16* P = (const h16*)(ws + WS_BIG); const h16* QB = (const h16*)(ws + WS_QB); const unsigned* BMP = (const unsigned*)(ws + WS_BM);
    h16* O = (h16*)(ws + WS_O); const float* lutg = (const float*)(ws + WS_LUT); const float* sscq = (const float*)(ws + WS_SS) + 7 * (size_t)M;
    LAS float* lut = (LAS float*)(lds + B2_LUT);
    const int r32 = lane & 31, hi = lane >> 5;
    for (int i = 0; i < 4; ++i)
        for (int uu = vcu; uu < 256; uu += G) {
            const int bh = uu >> 1, par = uu & 1; const int b = bh >> 3, h = bh & 7;
            const int qb = (i == 0) ? par : (i == 1) ? 7 - par : (i == 2) ? 2 + par : 5 - par;
            const long rowb = (long)b * SEQ; const int q0w = 256 * qb + 32 * wave; const int tq = q0w + r32; const long qtok = rowb + tq;
            for (int x = tid; x < 2080; x += NTHREADS) lut[x] = (x >= 32) ? lutg[(8 + h) * LUTP + x - 32] : 0.f;
            h16x8 qf[4];
#pragma unroll
            for (int ks = 0; ks < 4; ++ks) qf[ks] = *(const h16x8*)(QB + (size_t)qtok * QBW + 64 * h + ks * 16 + hi * 8);
            const float scl = __builtin_amdgcn_rsqf(sscq[qtok] * (1.0f / 256.0f) + EPS) * QSCALE2;
            const int nch = 2 * qb + 2;
            fill_kv<128>(lds + B2_K, lds + B2_V, P, rowb, 1, EINP, E_KB + 64 * h, E_VB + 64 * h, 0, 128, tid, NTHREADS);
            __syncthreads();
            float mrun = -1e30f, lrun = 0.f; f32x16 o[2]; o[0] = f32x16{}; o[1] = f32x16{};
            const int laneb = r32 - 4 * hi + 5;
            for (int c = 0; c < nch; ++c) {
                const LAS unsigned char* Kimg = lds + B2_K + (c & 1) * KVImg<128>::KBYTES; const LAS unsigned char* Vimg = lds + B2_V + (c & 1) * KVImg<128>::VBYTES;
                u32x4 pk[2], pv[2];
                const bool more = c + 1 < nch;
                if (more) {
#pragma unroll
                    for (int z = 0; z < 2; ++z) { const int p = tid + z * NTHREADS; const int row = p >> 3, cc = p & 7; const h16* g = P + (size_t)(rowb + 128 * (c + 1) + row) * EINP + cc * 8;
                        pk[z] = *(const u32x4*)(g + E_KB + 64 * h); pv[z] = *(const u32x4*)(g + E_VB + 64 * h); }
                }
                const u32x4 bw = *(const u32x4*)(BMP + (size_t)qtok * 64 + 4 * c);
#pragma unroll
                for (int j = 0; j < 4; ++j) {
                    const int k0 = 128 * c + 32 * j;
                    if (k0 <= q0w) {
                        const f32x16 acc = qk_tile<128>(Kimg, 32 * j, qf, r32, hi);
                        const unsigned wsh = bw[j] >> (4 * hi);
                        const LAS float* lp = lut + laneb + (q0w - k0);
                        f32x16 s; float mx = -INFINITY;
#pragma unroll
                        for (int r = 0; r < 16; ++r) { float v = acc[r] * scl + lp[27 - crow_c(r)]; v = ((wsh >> crow_c(r)) & 1u) ? v : -INFINITY; s[r] = v; mx = fmaxf(mx, v); }
                        mx = fmaxf(mx, xhalf(mx));
                        const float mnew = fmaxf(mrun, mx); const float alpha = ex2(mrun - mnew); mrun = mnew;
                        float ls = 0.f;
#pragma unroll
                        for (int r = 0; r < 16; ++r) { const float p = ex2(s[r] - mnew); s[r] = p; ls += p; }
                        ls += xhalf(ls); lrun = lrun * alpha + ls;
#pragma unroll
                        for (int r = 0; r < 16; ++r) { o[0][r] *= alpha; o[1][r] *= alpha; }
                        pv_tile<128>(o, Vimg, 32 * j, s, lane, hi);
                    }
                }
                if (more) {
                    LAS unsigned char* Kn = lds + B2_K + ((c + 1) & 1) * KVImg<128>::KBYTES; LAS unsigned char* Vn = lds + B2_V + ((c + 1) & 1) * KVImg<128>::VBYTES;
#pragma unroll
                    for (int z = 0; z < 2; ++z) { const int p = tid + z * NTHREADS; const int row = p >> 3, cc = p & 7;
                        *(LAS u32x4*)(Kn + cc * KVImg<128>::KCH + row * 16) = pk[z]; *(LAS u32x4*)(Vn + (cc >> 2) * KVImg<128>::VDH + row * 64 + (cc & 3) * 16) = pv[z]; }
                }
                __syncthreads();
            }
            const float inv = 1.0f / lrun;
            h16* orow = O + (size_t)qtok * DM + 512 + 64 * h;
#pragma unroll
            for (int d0 = 0; d0 < 2; ++d0)
#pragma unroll
                for (int g4 = 0; g4 < 4; ++g4) { u32x2 w; w.x = pkh(o[d0][4 * g4 + 0] * inv, o[d0][4 * g4 + 1] * inv); w.y = pkh(o[d0][4 * g4 + 2] * inv, o[d0][4 * g4 + 3] * inv);
                    *(u32x2*)(orow + 32 * d0 + 8 * g4 + 4 * hi) = w; }
        }
}

__global__ void __launch_bounds__(NTHREADS, 2) fwd_kernel(Args args) {
    extern __shared__ __attribute__((aligned(16))) unsigned char lds_raw[];
    {   LAS unsigned char* lds0 = (LAS unsigned char*)lds_raw;
        for (int u = threadIdx.x; u < (LDS_BYTES - LDSCTL_OFF) / 4; u += NTHREADS) ((LAS unsigned*)(lds0 + LDSCTL_OFF))[u] = 0u;
        __syncthreads();
        if (!MK_PER_PHASE) (void)xcd_barrier_post((unsigned*)((gu32*)(args.ws + WS_CTL) + CW_BAR), (volatile LAS unsigned*)(lds0 + MISC_OFF) + 8);
    }
    const int lo = args.ph_lo, hi = args.ph_hi;
    int ph = 0;
#define PH_BEGIN if (ph >= lo && ph < hi) { \
        int tid = threadIdx.x; asm volatile("" : "+v"(tid)); const int lane = tid & 63, wave = __builtin_amdgcn_readfirstlane(tid >> 6); \
        GAS unsigned char* wsg_ = (GAS unsigned char*)args.ws; asm volatile("" : "+s"(wsg_)); unsigned char* ws = (unsigned char*)wsg_; \
        LAS unsigned char* lds = (LAS unsigned char*)lds_raw; \
        const int G = gridDim.x, bx = blockIdx.x; const int vcu = (G % 8 == 0) ? (bx % 8) * (G / 8) + bx / 8 : bx; \
        h16* wb = (h16*)(ws + WS_W); h16* XN = (h16*)(ws + WS_XN); h16* BIG = (h16*)(ws + WS_BIG); h16* OB = (h16*)(ws + WS_O); h16* QBB = (h16*)(ws + WS_QB); float* SS = (float*)(ws + WS_SS); \
        (void)lane; (void)wave; (void)vcu; (void)wb; (void)XN; (void)BIG; (void)OB; (void)QBB; (void)SS; (void)lds;
#define PH_END   if (!MK_PER_PHASE && ph + 1 < hi) { XcdBarrier bar; bar.bar = (unsigned*)((gu32*)(ws + WS_CTL) + CW_BAR); bar.x = xb_xcc_id(); bar.st = (volatile LAS unsigned*)(lds + MISC_OFF) + 8; xcd_barrier(bar); } } ++ph;

    PH_BEGIN
        if (MK_ONLY & 1) prologue(args, ws, lds, vcu * NWAVES + wave, G * NWAVES, wave, lane);
    PH_END

    for (int step = 0; step < 4; ++step) {
        const int l = step >> 1, j = step & 1;
        const int ssi = (l == 0) ? (j == 0 ? 0 : 2) : (j == 0 ? 3 : 5);
        PH_BEGIN
            pg8::Gemm g{XN, wb + (WO_W13 + (size_t)(2 * l + j) * W13_BYTES) / 2, DM, DM, DM}; pg8::StaticOrder S; S.init(M, 2 * FF, G, bx);
            pg8::EpiSwiGLU E{BIG, FF, SS + (size_t)ssi * M};
            if (MK_ONLY & 2) pg8::gemm_phase<pg8::EpiSwiGLU, true>(lds, tid, g, S, E);
        PH_END
        PH_BEGIN
            pg8::Gemm g{BIG, wb + (WO_W2 + (size_t)(2 * l + j) * W2_BYTES) / 2, FF, FF, FF}; pg8::StaticOrder S; S.init(M, DM, G, bx);
            pg8::EpiResid E{step == 0 ? args.x : args.out, args.out, XN, SS + (size_t)(ssi + 1) * M, 0.5f};
            if (MK_ONLY & 4) pg8::gemm_phase<pg8::EpiResid, true>(lds, tid, g, S, E);
        PH_END
        if (j == 0) {
            const int ssm = ssi + 1;
            PH_BEGIN
                if (!((l == 0 && (MK_SKIP & 8)) || (l == 1 && (MK_SKIP & 16)))) {
                pg8::Gemm g{XN, wb + (l == 0 ? WO_WINE : WO_WINO) / 2, DM, DM, DM}; pg8::StaticOrder S; S.init(M, l == 0 ? EINP : OIN, G, bx);
                pg8::EpiH16 E{BIG, l == 0 ? EINP : OIN, SS + (size_t)ssm * M, l == 0 ? SS + (size_t)7 * M : nullptr, E_CQ / 256};
                if (MK_ONLY & 8) pg8::gemm_phase<pg8::EpiH16, true>(lds, tid, g, S, E);
                }
            PH_END
            if (l == 0) {
                PH_BEGIN
                    if (!(MK_SKIP & (8 | 2))) {
                    pg8::Gemm g{BIG + E_CQ, wb + WO_WQ / 2, EINP, 256, 256}; pg8::StaticOrder S; S.init(M, QBW, G, bx);
                    pg8::EpiH16 E{QBB, QBW, nullptr, nullptr, -1};
                    if (MK_ONLY & 16) pg8::gemm_phase<pg8::EpiH16, true>(lds, tid, g, S, E);
                    }
                PH_END
                for (int br = 0; br < 3; ++br) {
                    PH_BEGIN
                        if ((MK_ONLY & 32) && !(MK_SKIP & (8 | 1))) phase_band_A(args, ws, lds, vcu, G, tid, wave, lane, br == 0 ? 16 : (br == 1 ? 4 : 1), br);
                    PH_END
                }
                PH_BEGIN
                    if ((MK_ONLY & 64) && !(MK_SKIP & (8 | 2))) phase_select(args, ws, lds, vcu, G, tid, wave, lane);
                PH_END
                PH_BEGIN
                    if ((MK_ONLY & 128) && !(MK_SKIP & (8 | 2))) phase_dsa(args, ws, lds, vcu, G, tid, wave, lane);
                PH_END
            } else {
                PH_BEGIN
                    if ((MK_ONLY & 256) && !(MK_SKIP & (16 | 4))) phase_band_C(args, ws, lds, vcu, G, tid, wave, lane);
                PH_END
            }
            PH_BEGIN
                pg8::Gemm g{OB, wb + (l == 0 ? WO_WOUTE : WO_WOUTO) / 2, DM, DM, DM}; pg8::StaticOrder S; S.init(M, DM, G, bx);
                const bool skip = (l == 0 && (MK_SKIP & 8)) || (l == 1 && (MK_SKIP & 16));
                pg8::EpiResid E{args.out, args.out, XN, SS + (size_t)(ssm + 1) * M, skip ? 0.0f : 1.0f};
                if (MK_ONLY & 512) pg8::gemm_phase<pg8::EpiResid, true>(lds, tid, g, S, E);
            PH_END
        }
    }
    PH_BEGIN
        const float* ss6 = SS + (size_t)6 * M; const int gw = vcu * NWAVES + wave, NGW = G * NWAVES;
        if (MK_ONLY & 1024) for (int m = gw; m < M; m += NGW) {
            const float rinv = __builtin_amdgcn_rsqf(ss6[m] * (1.0f / DM) + EPS);
            f32x4* xr = (f32x4*)(args.out + (size_t)m * DM) + lane; const f32x4* gr = (const f32x4*)args.final_g + lane;
#pragma unroll
            for (int jj = 0; jj < 4; ++jj) { const f32x4 v = xr[64 * jj]; const f32x4 gg = gr[64 * jj]; xr[64 * jj] = v * rinv * gg; }
        }
    PH_END
#undef PH_BEGIN
#undef PH_END
}
constexpr int N_PHASES = 1 + 4 * 2 + (1 + 1 + 3 + 2 + 1) + (1 + 1 + 1) + 1;

extern "C" void kernel_launch(void* const* d_in, const int* in_sizes, int n_in, void* d_out, int out_size, void* d_ws, size_t ws_size, hipStream_t stream) {
    static int grid = 0;
    if (grid == 0) {
        if (n_in != 15 || in_sizes[0] != M * DM || out_size != M * DM || ws_size < WS_END) { fprintf(stderr, "kernel_launch: unexpected shapes / workspace (%d inputs, ws %zu)\n", n_in, ws_size); grid = -1; return; }
        int dev = 0, cus = 0, per_cu = 0;
        if (hipGetDevice(&dev) != hipSuccess || hipDeviceGetAttribute(&cus, hipDeviceAttributeMultiprocessorCount, dev) != hipSuccess) { grid = -1; return; }
        if (hipFuncSetAttribute((const void*)fwd_kernel, hipFuncAttributeMaxDynamicSharedMemorySize, LDS_BYTES) != hipSuccess) { fprintf(stderr, "kernel_launch: hipFuncSetAttribute failed\n"); grid = -1; return; }
        if (hipOccupancyMaxActiveBlocksPerMultiprocessor(&per_cu, (const void*)fwd_kernel, NTHREADS, LDS_BYTES) != hipSuccess || per_cu < 1) { fprintf(stderr, "kernel_launch: occupancy query says %d\n", per_cu); }
        (void)hipGetLastError();
        grid = cus;
    }
    if (grid < 0) return;
    if (hipMemsetAsync((char*)d_ws + WS_CTL, 0, CTL_ZERO_BYTES, stream) != hipSuccess) return;
    Args a{};
    a.x = (const float*)d_in[0]; a.norm_g = (const float*)d_in[1]; a.final_g = (const float*)d_in[2]; a.table = (const float*)d_in[3];
    a.w1 = (const float*)d_in[4]; a.w3 = (const float*)d_in[5]; a.w2 = (const float*)d_in[6];
    a.hyb_w_in = (const float*)d_in[7]; a.hyb_cq_g = (const float*)d_in[8]; a.hyb_wq_b = (const float*)d_in[9]; a.hyb_wq_idx = (const float*)d_in[10]; a.hyb_w_out = (const float*)d_in[11];
    a.swa_w_in = (const float*)d_in[12]; a.swa_sinks = (const float*)d_in[13]; a.swa_w_out = (const float*)d_in[14];
    a.out = (float*)d_out; a.ws = (unsigned char*)d_ws;
#if MK_PER_PHASE
    for (int p = 0; p < N_PHASES; ++p) { a.ph_lo = p; a.ph_hi = p + 1; hipLaunchKernelGGL(fwd_kernel, dim3(grid), dim3(NTHREADS), LDS_BYTES, stream, a); }
#else
    a.ph_lo = 0; a.ph_hi = N_PHASES;
    hipLaunchKernelGGL(fwd_kernel, dim3(grid), dim3(NTHREADS), LDS_BYTES, stream, a);
#endif
}
```

```cpp
#include <hip/hip_runtime.h>
#include <cstdio>
#include <cstdint>

#define LAS __attribute__((address_space(3)))
#define GAS __attribute__((address_space(1)))
typedef _Float16 h16;
typedef _Float16 h16x8 __attribute__((ext_vector_type(8)));
typedef _Float16 h16x4 __attribute__((ext_vector_type(4)));
typedef _Float16 h16x2 __attribute__((ext_vector_type(2)));
typedef short s16x2 __attribute__((ext_vector_type(2)));
typedef float f32x2 __attribute__((ext_vector_type(2)));
typedef float f32x4 __attribute__((ext_vector_type(4)));
typedef float f32x16 __attribute__((ext_vector_type(16)));
typedef unsigned u32x2 __attribute__((ext_vector_type(2)));
typedef unsigned u32x4 __attribute__((ext_vector_type(4)));
typedef short v4i16_t __attribute__((ext_vector_type(4)));
typedef GAS unsigned gu32;

#ifndef MK_PER_PHASE
#define MK_PER_PHASE 0
#endif
#ifndef MK_ONLY
#define MK_ONLY 0xFFFF
#endif
#ifndef MK_PROBE
#define MK_PROBE 0
#endif
#ifndef MK_SKIP
#define MK_SKIP 0
#endif

constexpr int NB = 16, SEQ = 2048, DM = 1024, FF = 2816, M = NB * SEQ;
constexpr int EIN = 2856, EINP = 3072, OIN = 1280, QBW = 768;
constexpr int E_CQ_TILE = 6;
constexpr int PJP = 1024, PJ_QA = 0, PJ_CQ = 512, PJ_KI = 768, PJ_WI = 800;
constexpr int KV_TS = 2 * 8 * 2048 * 64;
constexpr int T_KA = 0, T_VA = 1, T_KB = 2, T_VB = 3;
constexpr int O_Q = 0, O_K = 1024, O_V = 1152;
constexpr float EPS = 1e-6f;
constexpr float LOG2E = 1.4426950408889634f;
constexpr float QSCALE2 = 0.125f * LOG2E;
constexpr int LUTP = 2112;

constexpr size_t MiB = 1u << 20;
constexpr size_t WS_CTL = 0, CTL_ZERO_BYTES = 3 * MiB;
constexpr size_t WS_SS = 1 * MiB;
typedef unsigned long long u64;
constexpr float SS_FIX = 16777216.0f, SS_UNFIX = 1.0f / 16777216.0f;
__device__ __forceinline__ u64 ss_fix(float s) { return (u64)(s * SS_FIX + 0.5f); }
__device__ __forceinline__ float ss_val(u64 v) { return (float)v * SS_UNFIX; }
constexpr size_t WS_LUT = 3 * MiB;
constexpr size_t WS_LSE = 3 * MiB + 512 * 1024;
constexpr size_t WS_W = 5 * MiB;
constexpr size_t W13_BYTES = (size_t)2 * FF * DM * 2, W2_BYTES = (size_t)DM * FF * 2;
constexpr size_t WO_W13 = 0, WO_W2 = WO_W13 + 4 * W13_BYTES, WO_WINE = WO_W2 + 4 * W2_BYTES, WO_WQ = WO_WINE + (size_t)EINP * DM * 2,
                 WO_WOUTE = WO_WQ + (size_t)QBW * 256 * 2, WO_WINO = WO_WOUTE + (size_t)DM * DM * 2, WO_WOUTO = WO_WINO + (size_t)OIN * DM * 2, WO_END = WO_WOUTO + (size_t)DM * DM * 2;
static_assert(WO_END <= 79 * MiB && 16 * LUTP * 4 <= 512 * 1024 && WS_LSE + (size_t)32768 * 8 * 4 <= WS_W, "low workspace map");
constexpr size_t WS_XN = 84 * MiB, WS_BIG = 148 * MiB, WS_O = 340 * MiB, WS_QB = 404 * MiB, WS_BM = 452 * MiB, WS_END = 460 * MiB;
static_assert(WS_XN + (size_t)M * DM * 2 <= WS_BIG && WS_BIG + (size_t)M * EINP * 2 <= WS_O && WS_O + (size_t)M * DM * 2 <= WS_QB && WS_QB + (size_t)M * QBW * 2 <= WS_BM && WS_BM + (size_t)M * 64 * 4 <= WS_END, "ws map");
constexpr int CW_TMO = 0, CW_BAR = 4096;

constexpr size_t BIG_SLAB = (size_t)4096 * EINP * 2;
__device__ __forceinline__ h16* big_view(unsigned char* ws, int grp, int pitch) { return (h16*)(ws + WS_BIG + (size_t)grp * BIG_SLAB) - (size_t)4096 * grp * pitch; }
__device__ __forceinline__ h16* kv_base(unsigned char* ws, int grp) { return (h16*)(ws + WS_BIG + (size_t)grp * BIG_SLAB + (size_t)4096 * PJP * 2); }
__device__ __forceinline__ h16* kv_rows(unsigned char* ws, int grp, int T, int b, int h) { return kv_base(ws, grp) + (size_t)T * KV_TS + ((size_t)((b & 1) * 8 + h) * 2048) * 64 - (size_t)b * 2048 * 64; }
constexpr int LDS_SCR = 151552;
constexpr int LDSCTL_OFF = LDS_SCR, MISC_OFF = LDSCTL_OFF + 320;
constexpr int LDS_BYTES = 155648;
constexpr int NWAVES = 8, NTHREADS = 512;

#define RLX_AGENT __ATOMIC_RELAXED, __HIP_MEMORY_SCOPE_AGENT
#define LDS_WAIT() asm volatile("s_waitcnt lgkmcnt(0)" ::: "memory")
#define VM_WAIT() asm volatile("s_waitcnt vmcnt(0)" ::: "memory")
__device__ __forceinline__ unsigned pkh(float lo, float hi) { f32x2 v = {lo, hi}; h16x2 h = __builtin_convertvector(v, h16x2); return __builtin_bit_cast(unsigned, h); }
typedef __bf16 bf16x8 __attribute__((ext_vector_type(8)));
typedef __bf16 bf16x2 __attribute__((ext_vector_type(2)));
__device__ __forceinline__ unsigned pkb(float lo, float hi) { f32x2 v = {lo, hi}; bf16x2 h = __builtin_convertvector(v, bf16x2); return __builtin_bit_cast(unsigned, h); }
__device__ __forceinline__ float bflo(unsigned w) { return __uint_as_float(w << 16); }
__device__ __forceinline__ float bfhi(unsigned w) { return __uint_as_float(w & 0xFFFF0000u); }
__device__ __forceinline__ float ex2(float x) { return __builtin_amdgcn_exp2f(x); }
__device__ __forceinline__ float xhalf(float v) { return __shfl_xor(v, 32); }
__device__ __forceinline__ float xhalf_max(float v) { auto rr = __builtin_amdgcn_permlane32_swap(__float_as_uint(v), __float_as_uint(v), false, false); const unsigned r0 = rr[0], r1 = rr[1]; return fmaxf(__uint_as_float(r0), __uint_as_float(r1)); }
__device__ __forceinline__ float xhalf_sum(float v) { auto rr = __builtin_amdgcn_permlane32_swap(__float_as_uint(v), __float_as_uint(v), false, false); const unsigned r0 = rr[0], r1 = rr[1]; return __uint_as_float(r0) + __uint_as_float(r1); }
__device__ __forceinline__ int crow_c(int r) { return (r & 3) + 8 * (r >> 2); }
__device__ __forceinline__ h16x8 pack8(float a0, float a1, float a2, float a3, float a4, float a5, float a6, float a7) {
    u32x4 w; w.x = pkh(a0, a1); w.y = pkh(a2, a3); w.z = pkh(a4, a5); w.w = pkh(a6, a7); return __builtin_bit_cast(h16x8, w);
}

namespace pg8 {
constexpr int BM = 256, BK = 64, HALF = 128, HTB = HALF * BK * 2, STAGE_BYTES = 8 * HTB, NXCD = 8, WGM = 8;
__host__ __device__ __forceinline__ int lds_byte(int r, int c) { const int st = (r >> 4) * 2 + (c >> 5), rr = r & 15, cc = c & 31, ob = rr * 64 + cc * 2; return st * 1024 + (ob ^ (((ob >> 9) & 1) << 5)); }
__host__ __device__ __forceinline__ void stage_rc(int b, int& R, int& C) { const int st = b / 1024, sb = b % 1024, swz = sb ^ (((sb >> 9) & 1) << 5); R = (st >> 1) * 16 + swz / 64; C = (st & 1) * 32 + (swz % 64) / 2; }
__host__ __device__ __forceinline__ int perm32(int rho) { const int n = rho >> 4, i = rho & 15; return 8 * (i >> 2) + 4 * n + (i & 3); }
struct Unit { int pm, pn; };
struct Gemm { const h16* A; const h16* Bt; int lda, ldb, K; };
struct StaticOrder {
    int nN, nwg, r, pm0;
    __device__ void init(int N, int grp, int r_) { nN = N / BM; nwg = 16 * nN; r = r_; pm0 = 16 * grp; }
    __device__ bool next(int i, Unit& u) const {
        const int L = i * 32 + r; if (L >= nwg) return false;
        const int nig = WGM * nN, gid = L / nig, rem = L % nig;
        u.pm = pm0 + gid * WGM + (rem % WGM); u.pn = rem / WGM; return true;
    }
};

struct EpiSwiGLU {
    static constexpr bool PERM = true, BF = true;
    h16* O; int ldc; const LAS float* rt; int rbase;
    __device__ __forceinline__ void operator()(const f32x4 (&acc)[2][2][4][2], const Unit& u, int wr, int wc, int fr, int fq) const {
        const int row0 = u.pm * BM + wr * 64 + fr, col0 = u.pn * HALF + wc * 32 + 8 * fq;
#pragma unroll
        for (int ai = 0; ai < 2; ++ai)
#pragma unroll
            for (int m = 0; m < 4; ++m) {
                const int row = row0 + ai * HALF + m * 16;
                const float rinv = rt[row - rbase];
                float o[8];
#pragma unroll
                for (int n = 0; n < 2; ++n)
#pragma unroll
                    for (int e = 0; e < 4; ++e) {
                        const float a = acc[ai][0][m][n][e] * rinv, b = acc[ai][1][m][n][e] * rinv;
                        o[4 * n + e] = a * b * __builtin_amdgcn_rcpf(1.0f + ex2(-a));
                    }
                u32x4 w; w.x = pkb(o[0], o[1]); w.y = pkb(o[2], o[3]); w.z = pkb(o[4], o[5]); w.w = pkb(o[6], o[7]);
                *(u32x4*)(O + (size_t)row * ldc + col0) = w;
            }
    }
};
struct EpiResid {
    static constexpr bool PERM = true, BF = true;
    h16* H; u64* ssout; float cmul;
    __device__ __forceinline__ void operator()(const f32x4 (&acc)[2][2][4][2], const Unit& u, int wr, int wc, int fr, int fq) const {
        const int row0 = u.pm * BM + wr * 64 + fr, col0 = u.pn * BM + wc * 32 + 8 * fq;
#pragma unroll
        for (int ai = 0; ai < 2; ++ai) {
            h16x8 hv[4][2];
#pragma unroll
            for (int m = 0; m < 4; ++m) { const h16* hp = H + (size_t)(row0 + ai * HALF + m * 16) * DM + col0; hv[m][0] = *(const h16x8*)hp; hv[m][1] = *(const h16x8*)(hp + HALF); }
#pragma unroll
            for (int m = 0; m < 4; ++m) {
                const int row = row0 + ai * HALF + m * 16; h16* hp = H + (size_t)row * DM + col0; float s = 0.f;
#pragma unroll
                for (int bj = 0; bj < 2; ++bj) {
                    const u32x4 hx = __builtin_bit_cast(u32x4, hv[m][bj]); float o[8];
#pragma unroll
                    for (int n = 0; n < 2; ++n)
#pragma unroll
                        for (int e = 0; e < 4; ++e) { const unsigned hw = hx[2 * n + (e >> 1)]; o[4 * n + e] = ((e & 1) ? bfhi(hw) : bflo(hw)) + acc[ai][bj][m][n][e] * cmul; }
                    u32x4 w; w.x = pkb(o[0], o[1]); w.y = pkb(o[2], o[3]); w.z = pkb(o[4], o[5]); w.w = pkb(o[6], o[7]);
                    *(u32x4*)(hp + bj * HALF) = w;
#pragma unroll
                    for (int e = 0; e < 4; ++e) { const float r0 = bflo(w[e]), r1 = bfhi(w[e]); s += r0 * r0; s += r1 * r1; }
                }
                s += __shfl_xor(s, 16); s += __shfl_xor(s, 32);
                if (fq == 0) (void)__hip_atomic_fetch_add(ssout + row, ss_fix(s), RLX_AGENT);
            }
            asm volatile("" ::: "memory");
        }
    }
};
struct EpiH16 {
    static constexpr bool PERM = true, BF = true;
    h16* O; int ldc; const LAS float* rt; int rbase; u64* sscq; int cq_pn;
    h16* kv;
    __device__ __forceinline__ void operator()(const f32x4 (&acc)[2][2][4][2], const Unit& u, int wr, int wc, int fr, int fq) const {
        const int row0 = u.pm * BM + wr * 64 + fr, col0 = u.pn * BM + wc * 32 + 8 * fq;
        const bool docq = (sscq != nullptr) && (u.pn == cq_pn);
        h16* dbase[2]; int dpitch[2]; bool iskv[2];
#pragma unroll
        for (int bj = 0; bj < 2; ++bj) {
            if (!kv) { dbase[bj] = O + col0 + bj * HALF; dpitch[bj] = ldc; iskv[bj] = false; }
            else {
                const int hc = 2 * u.pn + bj, cin = wc * 32 + 8 * fq;
                int T = -1, hb = 0, pjcol = 0;
                if (hc < 4) pjcol = PJ_QA + hc * HALF;
                else if (hc < 12) { T = (hc - 4) >> 2; hb = ((hc - 4) & 3) * 2; }
                else if (hc < 14) pjcol = PJ_CQ + (hc - 12) * HALF;
                else if (hc < 22) { T = 2 + ((hc - 14) >> 2); hb = ((hc - 14) & 3) * 2; }
                else pjcol = PJ_KI + (hc - 22) * HALF;
                if (T < 0) { dbase[bj] = O + pjcol + cin; dpitch[bj] = PJP; iskv[bj] = false; }
                else { dbase[bj] = kv + (size_t)T * KV_TS + (size_t)(hb + (wc >> 1)) * 2048 * 64 + (wc & 1) * 32 + 8 * fq; dpitch[bj] = 64; iskv[bj] = true; }
            }
        }
#pragma unroll
        for (int ai = 0; ai < 2; ++ai)
#pragma unroll
            for (int m = 0; m < 4; ++m) {
                const int row = row0 + ai * HALF + m * 16;
                const float rinv = rt ? rt[row - rbase] : 1.0f;
                float s = 0.f;
#pragma unroll
                for (int bj = 0; bj < 2; ++bj) {
                    const f32x4 v0 = acc[ai][bj][m][0] * rinv, v1 = acc[ai][bj][m][1] * rinv;
                    u32x4 w; w.x = pkh(v0[0], v0[1]); w.y = pkh(v0[2], v0[3]); w.z = pkh(v1[0], v1[1]); w.w = pkh(v1[2], v1[3]);
                    const size_t off = iskv[bj] ? ((size_t)((row >> 11) & 1) * (8 * 2048 * 64) + (size_t)(row & 2047) * 64) : (size_t)row * dpitch[bj];
                    *(u32x4*)(dbase[bj] + off) = w;
                    s += (v0[0] * v0[0] + v0[1] * v0[1]) + (v0[2] * v0[2] + v0[3] * v0[3]) + (v1[0] * v1[0] + v1[1] * v1[1]) + (v1[2] * v1[2] + v1[3] * v1[3]);
                }
                if (docq) { s += __shfl_xor(s, 16); s += __shfl_xor(s, 32); if (fq == 0) (void)__hip_atomic_fetch_add(sscq + row, ss_fix(s), RLX_AGENT); }
            }
    }
};
struct EpiPlainH16 {
    static constexpr bool PERM = true, BF = false;
    h16* O; int ldc;
    __device__ __forceinline__ void operator()(const f32x4 (&acc)[2][2][4][2], const Unit& u, int wr, int wc, int fr, int fq) const {
        const int row0 = u.pm * BM + wr * 64 + fr, col0 = u.pn * BM + wc * 32 + 8 * fq;
#pragma unroll
        for (int ai = 0; ai < 2; ++ai)
#pragma unroll
            for (int m = 0; m < 4; ++m) {
                h16* op = O + (size_t)(row0 + ai * HALF + m * 16) * ldc + col0;
#pragma unroll
                for (int bj = 0; bj < 2; ++bj) {
                    const f32x4 v0 = acc[ai][bj][m][0], v1 = acc[ai][bj][m][1];
                    u32x4 w; w.x = pkh(v0[0], v0[1]); w.y = pkh(v0[2], v0[3]); w.z = pkh(v1[0], v1[1]); w.w = pkh(v1[2], v1[3]);
                    *(u32x4*)(op + bj * HALF) = w;
                }
            }
    }
};
template <bool BF> __device__ __forceinline__ f32x4 mma16(const h16x8& a, const h16x8& b, const f32x4& c) {
    if constexpr (BF) return __builtin_amdgcn_mfma_f32_16x16x32_bf16(__builtin_bit_cast(bf16x8, a), __builtin_bit_cast(bf16x8, b), c, 0, 0, 0);
    else return __builtin_amdgcn_mfma_f32_16x16x32_f16(a, b, c, 0, 0, 0);
}
constexpr int RT_OFF = STAGE_BYTES;
__device__ __forceinline__ const LAS float* stage_rinv(LAS unsigned char* lds, const u64* ss, int rbase, int tid) {
    LAS float* rt = (LAS float*)(lds + RT_OFF);
#pragma unroll
    for (int i = 0; i < 8; ++i) rt[tid + 512 * i] = __builtin_amdgcn_rsqf(ss_val(ss[rbase + tid + 512 * i]) * (1.0f / DM) + EPS);
    __syncthreads();
    return rt;
}
template <class Epi, bool ALIGN_EPI>
__device__ __forceinline__ void gemm_phase(LAS unsigned char* lds, const int tid, const Gemm g, const StaticOrder& S, const Epi& E) {
    const int wid = __builtin_amdgcn_readfirstlane(tid >> 6), lane = tid & 63, wr = wid >> 2, wc = wid & 3, fr = lane & 15, fq = lane >> 4;
    const int K = g.K, nt = K / BK;
    unsigned voffA[2], voffB[2];
#pragma unroll
    for (int i = 0; i < 2; ++i) { int R, C; stage_rc(tid * 16 + i * 8192, R, C); const int Rb = Epi::PERM ? ((R & ~31) + perm32(R & 31)) : R;
        voffA[i] = (unsigned)(R * g.lda + C) * 2u; voffB[i] = (unsigned)(Rb * g.ldb + C) * 2u; }
    const size_t kstep = (size_t)(BK * 2);
    const size_t hstepA = (size_t)HALF * g.lda * 2, hstepB = (size_t)HALF * g.ldb * 2;
    const size_t tstepA = 2 * hstepA, tstepB = 2 * hstepB;
    const unsigned ldsw = (unsigned)wid * 1024u;
    const int aoff = lds_byte(wr * 64 + fr, fq * 8), boff = lds_byte(wc * 32 + fr, fq * 8);
#define PG8_SA(b, h) (((b) * 2 + (h)) * HTB)
#define PG8_SB(b, h) ((4 + (b) * 2 + (h)) * HTB)
#define PG8_STAGE(bufoff, gbase, voff) do { _Pragma("unroll") for (int _i = 0; _i < 2; ++_i) \
        __builtin_amdgcn_global_load_lds((const unsigned*)((const char*)(gbase) + (voff)[_i]), (LAS unsigned*)(lds + (bufoff) + ldsw + _i * 8192), 16, 0, 0); } while (0)
#define PG8_LDA(dst, b, h) do { _Pragma("unroll") for (int m = 0; m < 4; ++m) _Pragma("unroll") for (int k = 0; k < 2; ++k) dst[m][k] = *(const LAS h16x8*)(lds + PG8_SA(b, h) + aoff + m * 2048 + k * 1024); } while (0)
#define PG8_LDB(dst, b, h) do { _Pragma("unroll") for (int n = 0; n < 2; ++n) _Pragma("unroll") for (int k = 0; k < 2; ++k) dst[n][k] = *(const LAS h16x8*)(lds + PG8_SB(b, h) + boff + n * 2048 + k * 1024); } while (0)
#define PG8_MMA(ai, bj, At, Bt) do { __builtin_amdgcn_s_setprio(1); _Pragma("unroll") for (int m = 0; m < 4; ++m) _Pragma("unroll") for (int n = 0; n < 2; ++n) _Pragma("unroll") for (int k = 0; k < 2; ++k) \
        acc[ai][bj][m][n] = mma16<Epi::BF>(Bt[n][k], At[m][k], acc[ai][bj][m][n]); __builtin_amdgcn_s_setprio(0); } while (0)
#define PG8_WAIT_V(n) asm volatile("s_waitcnt vmcnt(" #n ")" ::: "memory")
#define PG8_WAIT_L(n) asm volatile("s_waitcnt lgkmcnt(" #n ")" ::: "memory")
#define PG8_BAR __builtin_amdgcn_s_barrier()
#define PG8_SCHED __builtin_amdgcn_sched_barrier(0)
    Unit cur, nxt; int ui = 0;
    if (!S.next(0, cur)) return;
    f32x4 acc[2][2][4][2];
#pragma unroll
    for (int a = 0; a < 2; ++a)
#pragma unroll
        for (int b = 0; b < 2; ++b)
#pragma unroll
            for (int m = 0; m < 4; ++m)
#pragma unroll
                for (int n = 0; n < 2; ++n) acc[a][b][m][n] = (f32x4){0.f, 0.f, 0.f, 0.f};
    h16x8 At[4][2], B0[2][2], B1[2][2];
    const char* cA = (const char*)g.A + (size_t)cur.pm * tstepA; const char* cB = (const char*)g.Bt + (size_t)cur.pn * tstepB;
    PG8_STAGE(PG8_SB(0, 0), cB, voffB); PG8_STAGE(PG8_SB(0, 1), cB + hstepB, voffB); PG8_STAGE(PG8_SA(0, 0), cA, voffA); PG8_STAGE(PG8_SA(0, 1), cA + hstepA, voffA);
    if (wr == 1) PG8_BAR;
    PG8_WAIT_V(2); PG8_BAR;
    PG8_STAGE(PG8_SB(1, 0), cB + kstep, voffB); PG8_STAGE(PG8_SA(1, 0), cA + kstep, voffA); PG8_STAGE(PG8_SB(1, 1), cB + hstepB + kstep, voffB);
    PG8_WAIT_V(6); PG8_BAR;
    for (;;) {
        const bool has_next = S.next(ui + 1, nxt);
        const char* nA = has_next ? (const char*)g.A + (size_t)nxt.pm * tstepA : cA; const char* nB = has_next ? (const char*)g.Bt + (size_t)nxt.pn * tstepB : cB;
        for (int t = 0; t < nt; t += 2) {
            const bool last = (t == nt - 2);
            const char* a1 = cA + (size_t)(t + 1) * kstep;
            const char* a2 = last ? nA : cA + (size_t)(t + 2) * kstep; const char* b2 = last ? nB : cB + (size_t)(t + 2) * kstep;
            const char* a3 = a2 + kstep; const char* b3 = b2 + kstep;
            PG8_LDB(B0, 0, 0); PG8_LDB(B1, 0, 1); PG8_SCHED; PG8_LDA(At, 0, 0); PG8_STAGE(PG8_SA(1, 1), a1 + hstepA, voffA);
            PG8_WAIT_V(8); PG8_WAIT_L(0); PG8_BAR; PG8_MMA(0, 0, At, B0); PG8_MMA(0, 1, At, B1); PG8_BAR; PG8_SCHED;
            PG8_LDA(At, 0, 1); PG8_STAGE(PG8_SB(0, 0), b2, voffB); PG8_STAGE(PG8_SB(0, 1), b2 + hstepB, voffB); PG8_STAGE(PG8_SA(0, 0), a2, voffA);
            PG8_WAIT_V(8); PG8_WAIT_L(0); PG8_BAR; PG8_MMA(1, 0, At, B0); PG8_MMA(1, 1, At, B1); PG8_BAR; PG8_SCHED;
            PG8_LDB(B0, 1, 0); PG8_LDB(B1, 1, 1); PG8_SCHED; PG8_LDA(At, 1, 0); PG8_STAGE(PG8_SA(0, 1), a2 + hstepA, voffA);
            PG8_WAIT_V(8); PG8_WAIT_L(0); PG8_BAR; PG8_MMA(0, 0, At, B0); PG8_MMA(0, 1, At, B1); PG8_BAR; PG8_SCHED;
            PG8_LDA(At, 1, 1); PG8_STAGE(PG8_SB(1, 0), b3, voffB); PG8_STAGE(PG8_SB(1, 1), b3 + hstepB, voffB); PG8_STAGE(PG8_SA(1, 0), a3, voffA);
            PG8_WAIT_V(8); PG8_WAIT_L(0); PG8_BAR; PG8_MMA(1, 0, At, B0); PG8_MMA(1, 1, At, B1); PG8_BAR; PG8_SCHED;
        }
        if constexpr (ALIGN_EPI) { if (wr == 0) PG8_BAR; }
        E(acc, cur, wr, wc, fr, fq);
        if (!has_next) break;
#pragma unroll
        for (int a = 0; a < 2; ++a)
#pragma unroll
            for (int b = 0; b < 2; ++b)
#pragma unroll
                for (int m = 0; m < 4; ++m)
#pragma unroll
                    for (int n = 0; n < 2; ++n) acc[a][b][m][n] = (f32x4){0.f, 0.f, 0.f, 0.f};
        cur = nxt; cA = nA; cB = nB; ++ui;
        if constexpr (ALIGN_EPI) { if (wr == 1) PG8_BAR; }
    }
    PG8_WAIT_V(0);
    if constexpr (!ALIGN_EPI) { if (wr == 0) PG8_BAR; }
    PG8_BAR;
#undef PG8_SA
#undef PG8_SB
#undef PG8_STAGE
#undef PG8_LDA
#undef PG8_LDB
#undef PG8_MMA
#undef PG8_WAIT_V
#undef PG8_WAIT_L
#undef PG8_BAR
#undef PG8_SCHED
}
}

#define XB_TMO      128
#define XB_XCNT(j)  (256  + 64 * (j))
#define XB_XSUB(j)  (1280 + 64 * (j))
#define XB_XGEN(j)  (2304 + 64 * (j))
#define XB_TOP      3328
#define XB_TOPGEN   3392
#define XCD_BAR_WORDS 3456
#define XB_SPIN_CAP (1u << 18)
__device__ __forceinline__ unsigned xb_ld(unsigned* p)              { return __hip_atomic_load(p, __ATOMIC_RELAXED, __HIP_MEMORY_SCOPE_AGENT); }
__device__ __forceinline__ unsigned xb_add(unsigned* p, unsigned v) { return __hip_atomic_fetch_add(p, v, __ATOMIC_RELAXED, __HIP_MEMORY_SCOPE_AGENT); }
__device__ __forceinline__ unsigned xb_xcc_id() { return (unsigned)__builtin_amdgcn_s_getreg((3 << 11) | 20) & 0xFu; }
#define XB_SPIN(cond, bar) do { unsigned _sp = 0; while (cond) { __builtin_amdgcn_s_sleep(1); \
    if ((++_sp & 255u) == 0u) { if (xb_ld(&(bar)[XB_TMO])) break; if (_sp > XB_SPIN_CAP) { atomicAdd(&(bar)[XB_TMO], 1u); break; } } } } while (0)
__device__ __forceinline__ void xcd_barrier_post(unsigned* bar) { if (threadIdx.x == 0) (void)xb_add(&bar[XB_XCNT(xb_xcc_id())], 1u); }
__device__ __forceinline__ void xcd_barrier_complete(unsigned* bar, unsigned x, unsigned G, unsigned& nloc, unsigned& nx) {
    unsigned sum, cnt, mine, sp = 0u;
    for (;;) {
        sum = 0u; cnt = 0u; mine = 0u;
#pragma unroll
        for (unsigned j = 0; j < 16; ++j) { const unsigned c = xb_ld(&bar[XB_XCNT(j)]); sum += c; cnt += (c > 0u) ? 1u : 0u; mine = (j == x) ? c : mine; }
        if (sum == G) break;
        __builtin_amdgcn_s_sleep(1);
        if ((++sp & 255u) == 0u) { if (xb_ld(&bar[XB_TMO])) break; if (sp > XB_SPIN_CAP) { atomicAdd(&bar[XB_TMO], 1u); break; } }
    }
    nloc = mine > 0u ? mine : 1u; nx = cnt > 0u ? cnt : 1u;
}
template <bool FAST>
__device__ __forceinline__ void xcd_barrier(unsigned* bar, volatile LAS unsigned* st, unsigned Gtot) {
    asm volatile("s_waitcnt vmcnt(0)" ::: "memory");
    __syncthreads();
    if (threadIdx.x == 0) {
        __builtin_amdgcn_s_waitcnt(0);
        const unsigned x = xb_xcc_id();
        unsigned nloc = st[0], nx = st[1];
        if (nloc == 0u) { xcd_barrier_complete(bar, x, Gtot, nloc, nx); st[0] = nloc; st[1] = nx; }
        const unsigned old = xb_add(&bar[XB_XSUB(x)], 1u);
        const unsigned gen = old / nloc;
        if (old + 1u == (gen + 1u) * nloc) {
            if (!(FAST && nx == 1u)) {
                __builtin_amdgcn_fence(__ATOMIC_RELEASE, "agent");
                asm volatile("s_waitcnt vmcnt(0)" ::: "memory");
                const unsigned og = xb_add(&bar[XB_TOP], 1u);
                const unsigned tg = og / nx;
                if (og + 1u == (tg + 1u) * nx) xb_add(&bar[XB_TOPGEN], 1u);
                else XB_SPIN(xb_ld(&bar[XB_TOPGEN]) == tg, bar);
            }
            __builtin_amdgcn_fence(__ATOMIC_ACQUIRE, "agent");
            xb_add(&bar[XB_XGEN(x)], 1u);
            asm volatile("s_waitcnt vmcnt(0)" ::: "memory");
        } else {
            XB_SPIN(xb_ld(&bar[XB_XGEN(x)]) == gen, bar);
            __builtin_amdgcn_fence(__ATOMIC_ACQUIRE, "agent");
            asm volatile("s_waitcnt vmcnt(0)" ::: "memory");
        }
    }
    __syncthreads();
}

struct Args {
    const float* x; const float* norm_g; const float* final_g; const float* table; const float* w1; const float* w3; const float* w2;
    const float* hyb_w_in; const float* hyb_cq_g; const float* hyb_wq_b; const float* hyb_wq_idx; const float* hyb_w_out;
    const float* swa_w_in; const float* swa_sinks; const float* swa_w_out;
    float* out; unsigned char* ws; int ph_lo, ph_hi;
};

struct TrItem { const float* src; const float* gain; h16* dst; int ldsrc, col0, nvalid, K, k0; float cs; int bf; };
__device__ __forceinline__ void tr_load(const TrItem& I, int lane, float (&tv)[32], float (&tg)[32]) {
    const int c = I.col0 + (lane & 31); const bool ok = c < I.nvalid;
#pragma unroll
    for (int i = 0; i < 32; ++i) { const int kk = 2 * i + (lane >> 5); tv[i] = ok ? I.src[(size_t)(I.k0 + kk) * I.ldsrc + c] : 0.f; tg[i] = (I.gain ? I.gain[I.k0 + kk] : 1.0f) * I.cs; }
}
__device__ __forceinline__ void tr_store(const TrItem& I, int lane, const float (&tv)[32], const float (&tg)[32], LAS float* scr) {
#pragma unroll
    for (int i = 0; i < 32; ++i) { const int kk = 2 * i + (lane >> 5); scr[kk * 33 + (lane & 31)] = tv[i] * tg[i]; }
    LDS_WAIT(); asm volatile("" ::: "memory");
    const int ch = lane & 7;
#pragma unroll
    for (int j = 0; j < 4; ++j) { const int n = (lane >> 3) + 8 * j; const LAS float* sp = scr + (8 * ch) * 33 + n;
        u32x4 o;
        if (I.bf) { o.x = pkb(sp[0 * 33], sp[1 * 33]); o.y = pkb(sp[2 * 33], sp[3 * 33]); o.z = pkb(sp[4 * 33], sp[5 * 33]); o.w = pkb(sp[6 * 33], sp[7 * 33]); }
        else { o.x = pkh(sp[0 * 33], sp[1 * 33]); o.y = pkh(sp[2 * 33], sp[3 * 33]); o.z = pkh(sp[4 * 33], sp[5 * 33]); o.w = pkh(sp[6 * 33], sp[7 * 33]); }
        *(u32x4*)(I.dst + (size_t)n * I.K + I.k0 + 8 * ch) = o; }
    LDS_WAIT(); asm volatile("" ::: "memory");
}
__device__ __forceinline__ int t5_bucket(int d) {
    if (d < 16) return d;
    int b = 16;
    b += (d >= 22) + (d >= 30) + (d >= 40) + (d >= 54) + (d >= 73) + (d >= 99) + (d >= 134) + (d >= 182) + (d >= 246) + (d >= 332) + (d >= 450) + (d >= 609) + (d >= 825) + (d >= 1117) + (d >= 1513);
    return b;
}
constexpr int PI13 = (DM / 64) * (2 * FF / 32), PI2 = (FF / 64) * (DM / 32), PIWE = (DM / 64) * (EINP / 32), PIWQ = (256 / 64) * (QBW / 32), PIWO = (DM / 64) * (DM / 32), PIWI = (DM / 64) * (OIN / 32);
constexpr int P_NITEMS = 4 * PI13 + 4 * PI2 + PIWE + PIWQ + PIWO + PIWI + PIWO;
__device__ __forceinline__ TrItem decode_item(const Args& a, h16* wb, int it) {
    TrItem I; I.cs = 1.0f; I.bf = 0; int r = it;
    if (r < 4 * PI13) { const int lj = r / PI13; r -= lj * PI13; const int l = lj >> 1, j = lj & 1; const int kb = r / 176, nb = r % 176, t = nb >> 3, wbk = nb & 7;
        I.src = (wbk < 4 ? a.w1 : a.w3) + (size_t)lj * DM * FF; I.ldsrc = FF; I.col0 = 128 * t + 32 * (wbk & 3); I.nvalid = FF; I.gain = a.norm_g + (l * 3 + 2 * j) * DM; I.K = DM; I.k0 = 64 * kb; I.cs = wbk < 4 ? LOG2E : 1.0f / LOG2E; I.bf = 1;

        I.dst = wb + (WO_W13 + lj * W13_BYTES) / 2 + (size_t)(32 * nb) * DM; return I; }
    r -= 4 * PI13;
    if (r < 4 * PI2) { const int lj = r / PI2; r -= lj * PI2; const int kb = r / 32, nb = r % 32;
        I.src = a.w2 + (size_t)lj * FF * DM; I.ldsrc = DM; I.col0 = 32 * nb; I.nvalid = DM; I.gain = nullptr; I.bf = 1; I.K = FF; I.k0 = 64 * kb; I.dst = wb + (WO_W2 + lj * W2_BYTES) / 2 + (size_t)(32 * nb) * FF; return I; }
    r -= 4 * PI2;
    if (r < PIWE) { const int kb = r / 96, nb = r % 96;
        I.src = a.hyb_w_in; I.ldsrc = EIN; I.col0 = 32 * nb; I.nvalid = EIN; I.gain = a.norm_g + 1 * DM; I.bf = 1; if (nb < 16) I.cs = QSCALE2;   I.K = DM; I.k0 = 64 * kb; I.dst = wb + WO_WINE / 2 + (size_t)(32 * nb) * DM; return I; }
    r -= PIWE;
    if (r < PIWQ) { const int kb = r / 24, nb = r % 24; I.gain = a.hyb_cq_g; I.K = 256; I.k0 = 64 * kb; I.dst = wb + WO_WQ / 2 + (size_t)(32 * nb) * 256;
        if (nb < 16) { I.src = a.hyb_wq_b; I.ldsrc = 512; I.col0 = 32 * nb; I.nvalid = 512; } else { I.src = a.hyb_wq_idx; I.ldsrc = 256; I.col0 = 32 * (nb - 16); I.nvalid = 256; }
        return I; }
    r -= PIWQ;
    if (r < PIWO) { const int kb = r / 32, nb = r % 32;
        I.src = a.hyb_w_out; I.ldsrc = DM; I.col0 = 32 * nb; I.nvalid = DM; I.gain = nullptr; I.bf = 1; I.K = DM; I.k0 = 64 * kb; I.dst = wb + WO_WOUTE / 2 + (size_t)(32 * nb) * DM; return I; }
    r -= PIWO;
    if (r < PIWI) { const int kb = r / 40, nb = r % 40;
        I.src = a.swa_w_in; I.ldsrc = OIN; I.col0 = 32 * nb; I.nvalid = OIN; I.gain = a.norm_g + (3 + 1) * DM; I.bf = 1; if (nb < 32) I.cs = QSCALE2;   I.K = DM; I.k0 = 64 * kb; I.dst = wb + WO_WINO / 2 + (size_t)(32 * nb) * DM; return I; }
    r -= PIWI;
    { const int kb = r / 32, nb = r % 32;
        I.src = a.swa_w_out; I.ldsrc = DM; I.col0 = 32 * nb; I.nvalid = DM; I.gain = nullptr; I.bf = 1; I.K = DM; I.k0 = 64 * kb; I.dst = wb + WO_WOUTO / 2 + (size_t)(32 * nb) * DM; return I; }
}
__device__ __forceinline__ void prologue(const Args& a, unsigned char* ws, LAS unsigned char* lds, int gw, int NGW, int wave, int lane) {
    LAS float* scr = (LAS float*)(lds + wave * 16384);
    h16* wb = (h16*)(ws + WS_W);
    if (gw < P_NITEMS) {
        TrItem cur = decode_item(a, wb, gw); float tv[32], tg[32];
        tr_load(cur, lane, tv, tg);
        for (int it = gw; it < P_NITEMS; it += NGW) {
            const bool more = it + NGW < P_NITEMS; TrItem nxt = cur; float nv[32], ng[32];
            if (more) { nxt = decode_item(a, wb, it + NGW); tr_load(nxt, lane, nv, ng); }
            tr_store(cur, lane, tv, tg, scr);
            if (more) { cur = nxt;
#pragma unroll
                for (int i = 0; i < 32; ++i) { tv[i] = nv[i]; tg[i] = ng[i]; } }
        }
    }
    { float* lut = (float*)(ws + WS_LUT);
      for (int i = gw * 64 + lane; i < 16 * LUTP; i += NGW * 64) { const int h = i / LUTP, d = i % LUTP; lut[i] = a.table[t5_bucket(d < 2048 ? d : 2047) * 16 + h] * LOG2E; } }
    { h16* XN = (h16*)(ws + WS_XN); u64* ss0 = (u64*)(ws + WS_SS);
      for (int m0 = gw; m0 < M; m0 += 4 * NGW) {
          f32x4 v[4][4];
#pragma unroll
          for (int r = 0; r < 4; ++r) { const int m = m0 + r * NGW; if (m < M) { const f32x4* xr = (const f32x4*)(a.x + (size_t)m * DM) + lane;
#pragma unroll
              for (int j = 0; j < 4; ++j) v[r][j] = xr[64 * j]; } }
#pragma unroll
          for (int r = 0; r < 4; ++r) { const int m = m0 + r * NGW; if (m < M) { float s = 0.f; u32x2* o8 = (u32x2*)(XN + (size_t)m * DM) + lane;
#pragma unroll
              for (int j = 0; j < 4; ++j) { const f32x4 x = v[r][j]; s += (x[0] * x[0] + x[1] * x[1]) + (x[2] * x[2] + x[3] * x[3]); u32x2 w; w.x = pkb(x[0], x[1]); w.y = pkb(x[2], x[3]); o8[64 * j] = w; }
#pragma unroll
              for (int o = 1; o < 64; o <<= 1) s += __shfl_xor(s, o);
              if (lane == 0) ss0[m] = ss_fix(s); } }
      } }
}

__device__ __forceinline__ h16x4 vtr(const LAS unsigned char* p) { return __builtin_bit_cast(h16x4, __builtin_amdgcn_ds_read_tr16_b64_v4i16((LAS v4i16_t*)p)); }
template <int NK> struct KVImg { static constexpr int KCH = NK * 16 + 16, KBYTES = 8 * KCH, VDH = NK * 64 + 64, VBYTES = 2 * VDH; };
template <int NK> __device__ __forceinline__ f32x16 qk_tile(const LAS unsigned char* Kimg, int kr0, const h16x8 (&qf)[4], int r32, int hi, f32x16 acc = f32x16{}) {
    const LAS unsigned char* kp = Kimg + hi * KVImg<NK>::KCH + (kr0 + r32) * 16;
#pragma unroll
    for (int ks = 0; ks < 4; ++ks) { const h16x8 kf = *(const LAS h16x8*)(kp + 2 * ks * KVImg<NK>::KCH); acc = __builtin_amdgcn_mfma_f32_32x32x16_f16(kf, qf[ks], acc, 0, 0, 0); }
    return acc;
}
template <int NK> __device__ __forceinline__ void pv_tile(f32x16 (&o)[2], const LAS unsigned char* Vimg, int kr0, const f32x16& p, int lane, int hi) {
    const LAS unsigned char* vp = Vimg + (kr0 + 4 * hi + ((lane & 15) >> 2)) * 64 + ((lane >> 4) & 1) * 32 + (lane & 3) * 8;
#pragma unroll
    for (int s = 0; s < 2; ++s) {
        const h16x8 pf = pack8(p[8 * s + 0], p[8 * s + 1], p[8 * s + 2], p[8 * s + 3], p[8 * s + 4], p[8 * s + 5], p[8 * s + 6], p[8 * s + 7]);
#pragma unroll
        for (int d0 = 0; d0 < 2; ++d0) {
            const h16x4 lo = vtr(vp + d0 * KVImg<NK>::VDH + s * 1024), hv = vtr(vp + d0 * KVImg<NK>::VDH + s * 1024 + 512);
            const h16x8 vf = {lo[0], lo[1], lo[2], lo[3], hv[0], hv[1], hv[2], hv[3]};
            o[d0] = __builtin_amdgcn_mfma_f32_32x32x16_f16(vf, pf, o[d0], 0, 0, 0);
        }
    }
}
template <int NK> __device__ __forceinline__ void pv_tile_pk(f32x16 (&o)[2], const LAS unsigned char* Vimg, int kr0, const unsigned (&pp)[8], int lane, int hi) {
    const LAS unsigned char* vp = Vimg + (kr0 + 4 * hi + ((lane & 15) >> 2)) * 64 + ((lane >> 4) & 1) * 32 + (lane & 3) * 8;
#pragma unroll
    for (int s = 0; s < 2; ++s) {
        const u32x4 pw = {pp[4 * s + 0], pp[4 * s + 1], pp[4 * s + 2], pp[4 * s + 3]};
        const h16x8 pf = __builtin_bit_cast(h16x8, pw);
#pragma unroll
        for (int d0 = 0; d0 < 2; ++d0) {
            const h16x4 lo = vtr(vp + d0 * KVImg<NK>::VDH + s * 1024), hv = vtr(vp + d0 * KVImg<NK>::VDH + s * 1024 + 512);
            const h16x8 vf = {lo[0], lo[1], lo[2], lo[3], hv[0], hv[1], hv[2], hv[3]};
            o[d0] = __builtin_amdgcn_mfma_f32_32x32x16_f16(vf, pf, o[d0], 0, 0, 0);
        }
    }
}
template <int NK> __device__ __forceinline__ void fill_kv(LAS unsigned char* Kimg, LAS unsigned char* Vimg, const h16* base, long grow0, int gstride, int ld, int kcol, int vcol, int r_lo, int r_hi, int tid, int nthr) {
    const int npieces = (r_hi - r_lo) * 8;
    for (int p = tid; p < npieces; p += nthr) {
        const int row = r_lo + (p >> 3), c = p & 7;
        const h16* g = base + (size_t)(grow0 + (long)row * gstride) * ld + c * 8;
        const u32x4 kv = *(const u32x4*)(g + kcol), vv = *(const u32x4*)(g + vcol);
        *(LAS u32x4*)(Kimg + c * KVImg<NK>::KCH + row * 16) = kv;
        *(LAS u32x4*)(Vimg + (c >> 2) * KVImg<NK>::VDH + row * 64 + (c & 3) * 16) = vv;
    }
}

struct BandTask {
    h16* orow;
    float* lsep;
    int mode; float sink2;
    int qsub; bool has_prev;
    int flip;
};
struct BandPre { h16x8 qf[4]; float lv[3]; };
__device__ __forceinline__ void band_prefetch(BandPre& B, const h16* qrow, const float* lutg, int dil, int maxd, int lane) {
    const int hi = lane >> 5;
#pragma unroll
    for (int ks = 0; ks < 4; ++ks) B.qf[ks] = *(const h16x8*)(qrow + ks * 16 + hi * 8);
#pragma unroll
    for (int j = 0; j < 3; ++j) { const int rel = lane + 64 * j - 31; const bool ok = rel >= 0 && rel <= maxd;
        const float v = lutg[(ok ? rel : 0) * dil]; B.lv[j] = ok ? v : -INFINITY; }
}
__device__ __forceinline__ void band_task(const BandTask& T, const BandPre& B, const LAS unsigned char* Kimg, const LAS unsigned char* Vimg, LAS float* lut, int lane) {
    const int r32 = lane & 31, hi = lane >> 5;
#pragma unroll
    for (int j = 0; j < 3; ++j) lut[lane + 64 * j] = B.lv[j];
    u32x2 oold[2][4]; float lold = 0.f;
    LDS_WAIT(); asm volatile("" ::: "memory");
    const int laneb = r32 - 4 * hi + 4;
    float mref = 0.f, l = 0.f; f32x16 o[2]; o[0] = f32x16{}; o[1] = f32x16{};
#pragma unroll
    for (int ii = 0; ii < 5; ++ii) {
        const int i = 4 - ii; const int kr0 = 32 * T.qsub + 32 * i;
        if (ii == 3 && (T.mode == 1 || T.mode == 2)) {
            lold = *T.lsep;
#pragma unroll
            for (int d0 = 0; d0 < 2; ++d0)
#pragma unroll
                for (int g4 = 0; g4 < 4; ++g4) oold[d0][g4] = *(const u32x2*)(T.orow + 32 * d0 + 8 * g4 + 4 * hi);
        }
        if (T.has_prev || kr0 >= 128) {
            f32x16 cin;
            { f32x2 p0, p1, p2, p3, p4, p5, p6, p7; const LAS float* la = lut + laneb + (128 - 32 * i);
              asm volatile("ds_read2_b32 %0, %1 offset0:27 offset1:26" : "=v"(p0) : "v"(la)); asm volatile("ds_read2_b32 %0, %1 offset0:25 offset1:24" : "=v"(p1) : "v"(la));
              asm volatile("ds_read2_b32 %0, %1 offset0:19 offset1:18" : "=v"(p2) : "v"(la)); asm volatile("ds_read2_b32 %0, %1 offset0:17 offset1:16" : "=v"(p3) : "v"(la));
              asm volatile("ds_read2_b32 %0, %1 offset0:11 offset1:10" : "=v"(p4) : "v"(la)); asm volatile("ds_read2_b32 %0, %1 offset0:9 offset1:8" : "=v"(p5) : "v"(la));
              asm volatile("ds_read2_b32 %0, %1 offset0:3 offset1:2" : "=v"(p6) : "v"(la)); asm volatile("ds_read2_b32 %0, %1 offset0:1 offset1:0" : "=v"(p7) : "v"(la));
              asm volatile("s_waitcnt lgkmcnt(0)" : "+v"(p0), "+v"(p1), "+v"(p2), "+v"(p3), "+v"(p4), "+v"(p5), "+v"(p6), "+v"(p7) :: "memory");
              cin[0] = p0[0] - mref; cin[1] = p0[1] - mref; cin[2] = p1[0] - mref; cin[3] = p1[1] - mref; cin[4] = p2[0] - mref; cin[5] = p2[1] - mref; cin[6] = p3[0] - mref; cin[7] = p3[1] - mref;
              cin[8] = p4[0] - mref; cin[9] = p4[1] - mref; cin[10] = p5[0] - mref; cin[11] = p5[1] - mref; cin[12] = p6[0] - mref; cin[13] = p6[1] - mref; cin[14] = p7[0] - mref; cin[15] = p7[1] - mref; }
            f32x16 s = qk_tile<256>(Kimg, kr0 ^ T.flip, B.qf, r32, hi, cin); float mx = -INFINITY;
#pragma unroll
            for (int r = 0; r < 16; ++r) mx = fmaxf(mx, s[r]);
            mx = xhalf_max(mx);
            if (ii == 0 || __any(mx > 8.0f)) {
                const float dl = (ii == 0) ? mx : fmaxf(mx, 0.f);
                mref += dl; const float alpha = ex2(-dl); l *= alpha;
#pragma unroll
                for (int r = 0; r < 16; ++r) { s[r] -= dl; o[0][r] *= alpha; o[1][r] *= alpha; }
            }
#pragma unroll
            for (int r = 0; r < 16; ++r) { const float p = ex2(s[r]); s[r] = p; l += p; }
            pv_tile<256>(o, Vimg, kr0 ^ T.flip, s, lane, hi);
        }
    }
    l = xhalf_sum(l);
    const float mx = mref;
    const float inv = 1.0f / l;
    float lse = mx + __builtin_amdgcn_logf(l);
    float wc = inv, wo = 0.f;
    if (T.mode == 1 || T.mode == 2) {
        const float m2 = fmaxf(lold, lse); const float eo = ex2(lold - m2), ec = ex2(lse - m2); const float den = eo + ec;
        wo = eo / den; wc = inv * ec / den; lse = m2 + __builtin_amdgcn_logf(den);
    } else if (T.mode == 3) {
        wc = inv / (1.0f + ex2(T.sink2 - lse));
    }
#pragma unroll
    for (int d0 = 0; d0 < 2; ++d0)
#pragma unroll
        for (int g4 = 0; g4 < 4; ++g4) {
            h16* op = T.orow + 32 * d0 + 8 * g4 + 4 * hi;
            float v0 = o[d0][4 * g4 + 0] * wc, v1 = o[d0][4 * g4 + 1] * wc, v2 = o[d0][4 * g4 + 2] * wc, v3 = o[d0][4 * g4 + 3] * wc;
            if (T.mode == 1 || T.mode == 2) { const u32x2 ov = oold[d0][g4]; v0 += wo * bflo(ov.x); v1 += wo * bfhi(ov.x); v2 += wo * bflo(ov.y); v3 += wo * bfhi(ov.y); }
            u32x2 w; w.x = pkb(v0, v1); w.y = pkb(v2, v3); *(u32x2*)op = w;
        }
    if ((T.mode == 0 || T.mode == 1) && hi == 0) *T.lsep = lse;
}

constexpr int BAND_K = 0, BAND_V = KVImg<256>::KBYTES, BAND_LUT = BAND_V + KVImg<256>::VBYTES, BAND_HALF = BAND_LUT + 4 * 768;
static_assert(2 * BAND_HALF <= LDS_SCR, "band LDS");
struct WinRegs { u32x4 k[8], v[8]; };
__device__ __forceinline__ void win_load(WinRegs& W, const h16* base, long grow0, int gstride, int ld, int kcol, int vcol, bool has_prev, int th, bool real) {
    const int c = th & 7, r0 = th >> 3;
#pragma unroll
    for (int z = 0; z < 8; ++z) { const bool ok = real && (has_prev || z >= 4); const int row = ok ? (r0 + 32 * z) : 128;
        const h16* g = base + (size_t)(grow0 + (long)row * gstride) * ld + (ok ? c * 8 : 0);
        W.k[z] = *(const u32x4*)(g + kcol); W.v[z] = *(const u32x4*)(g + vcol); }
}
__device__ __forceinline__ void win_store(const WinRegs& W, LAS unsigned char* Kimg, LAS unsigned char* Vimg, int th) {
    const int c = th & 7, r0 = th >> 3;
#pragma unroll
    for (int z = 0; z < 8; ++z) { const int row = r0 + 32 * z;
        *(LAS u32x4*)(Kimg + c * KVImg<256>::KCH + row * 16) = W.k[z];
        *(LAS u32x4*)(Vimg + (c >> 2) * KVImg<256>::VDH + row * 64 + (c & 3) * 16) = W.v[z]; }
}

struct SubA { long rowbase; int jb, h; };
__device__ __forceinline__ SubA decode_A(int sub, int dil, int nblk) { SubA d; d.jb = sub % nblk; int t = sub / nblk; d.h = t & 7; t >>= 3; const int r = t % dil, b = t / dil; d.rowbase = (long)b * SEQ + r; return d; }
struct BlkRegs { u32x4 k[4], v[4]; };
__device__ __forceinline__ void blk_load(BlkRegs& R, const h16* base, long grow0, int gstride, bool real, int th) {
    const int c = th & 7, r0 = th >> 3;
#pragma unroll
    for (int z = 0; z < 4; ++z) { const int row = real ? (r0 + 32 * z) : 0;
        const h16* g = base + (size_t)(grow0 + (long)row * gstride) * 64 + (real ? c * 8 : 0);
        R.k[z] = *(const u32x4*)g; R.v[z] = *(const u32x4*)(g + KV_TS); }
}
__device__ __forceinline__ void blk_store(const BlkRegs& R, LAS unsigned char* Kimg, LAS unsigned char* Vimg, int slot, int th) {
    const int c = th & 7, r0 = th >> 3;
#pragma unroll
    for (int z = 0; z < 4; ++z) { const int row = 128 * slot + r0 + 32 * z;
        *(LAS u32x4*)(Kimg + c * KVImg<256>::KCH + row * 16) = R.k[z];
        *(LAS u32x4*)(Vimg + (c >> 2) * KVImg<256>::VDH + row * 64 + (c & 3) * 16) = R.v[z]; }
}
__device__ __forceinline__ void phase_band_A(const Args& a, unsigned char* ws, LAS unsigned char* lds, int vcu, int G, int tid, int wave, int lane, int dil, int mode) {
    const int half = wave >> 2, wq = wave & 3, th = tid & 255;
    LAS unsigned char* hb = lds + half * BAND_HALF;
    const h16* P = big_view(ws, vcu >> 5, PJP); h16* O = (h16*)(ws + WS_O); float* LSE = (float*)(ws + WS_LSE); const float* lutg = (const float*)(ws + WS_LUT);
    const int nblk = (SEQ / dil) / 128;
    const int grp = vcu >> 5, rnk = vcu & 31; const int S0 = 256 * grp + 4 * (2 * rnk + half);
    BlkRegs RA, RB; BandPre pre;
#define A_KBASE(d) kv_rows(ws, grp, T_KA, (int)((d).rowbase >> 11), (d).h)
#define A_OWN(d) ((d).rowbase + (long)(128 * (d).jb) * dil)
#define A_QROW(d) ((d).rowbase + (long)(128 * (d).jb + 32 * wq + (lane & 31)) * dil)
    { const SubA d0 = decode_A(S0, dil, nblk);
      blk_load(RA, A_KBASE(d0), A_OWN(d0) - (d0.jb > 0 ? (long)128 * dil : 0), dil, d0.jb > 0, th);
      blk_load(RB, A_KBASE(d0), A_OWN(d0), dil, true, th);
      band_prefetch(pre, P + (size_t)A_QROW(d0) * PJP + PJ_QA + 64 * d0.h, lutg + d0.h * LUTP, dil, 128, lane);
      blk_store(RA, hb + BAND_K, hb + BAND_V, 1, th); blk_store(RB, hb + BAND_K, hb + BAND_V, 0, th);
      __syncthreads();
      const SubA d1 = decode_A(S0 + 1, dil, nblk), d2 = decode_A(S0 + 2, dil, nblk);
      blk_load(RA, A_KBASE(d1), A_OWN(d1), dil, true, th); blk_load(RB, A_KBASE(d2), A_OWN(d2), dil, true, th); }
    for (int pp = 0; pp < 2; ++pp) {
        const SubA dk = decode_A(S0 + 2 * pp, dil, nblk), dk1 = decode_A(S0 + 2 * pp + 1, dil, nblk);
        const SubA dk2 = decode_A(S0 + (pp == 0 ? 2 : 3), dil, nblk), dk3 = decode_A(S0 + 3, dil, nblk);
        {
            const long qtok = A_QROW(dk);
            BandTask T; T.orow = O + (size_t)qtok * DM + 64 * dk.h; T.lsep = LSE + (size_t)qtok * 8 + dk.h; T.mode = mode; T.sink2 = 0.f; T.qsub = wq; T.has_prev = dk.jb > 0; T.flip = 128;
            band_task(T, pre, hb + BAND_K, hb + BAND_V, (LAS float*)(hb + BAND_LUT + wq * 768), lane);
            band_prefetch(pre, P + (size_t)A_QROW(dk1) * PJP + PJ_QA + 64 * dk1.h, lutg + dk1.h * LUTP, dil, 128, lane);
        }
        __syncthreads();
        blk_store(RA, hb + BAND_K, hb + BAND_V, 1, th);
        __syncthreads();
        blk_load(RA, A_KBASE(dk3), A_OWN(dk3), dil, pp == 0, th);
        {
            const long qtok = A_QROW(dk1);
            BandTask T; T.orow = O + (size_t)qtok * DM + 64 * dk1.h; T.lsep = LSE + (size_t)qtok * 8 + dk1.h; T.mode = mode; T.sink2 = 0.f; T.qsub = wq; T.has_prev = dk1.jb > 0; T.flip = 0;
            band_task(T, pre, hb + BAND_K, hb + BAND_V, (LAS float*)(hb + BAND_LUT + wq * 768), lane);
            band_prefetch(pre, P + (size_t)A_QROW(dk2) * PJP + PJ_QA + 64 * dk2.h, lutg + dk2.h * LUTP, dil, 128, lane);
        }
        __syncthreads();
        if (pp == 0) blk_store(RB, hb + BAND_K, hb + BAND_V, 0, th);
        __syncthreads();
    }
#undef A_KBASE
#undef A_OWN
#undef A_QROW
}

__device__ __forceinline__ void phase_band_C(const Args& a, unsigned char* ws, LAS unsigned char* lds, int vcu, int G, int tid, int wave, int lane) {
    const int half = wave >> 2, wq = wave & 3, th = tid & 255;
    LAS unsigned char* hb = lds + half * BAND_HALF;
    const h16* P = big_view(ws, vcu >> 5, OIN); h16* O = (h16*)(ws + WS_O); const float* lutg = (const float*)(ws + WS_LUT);
    WinRegs W; BandPre pre;
    { const int sub = 2 * vcu + half, jb = sub & 15, kvh = (sub >> 4) & 1, b = sub >> 5; const long rowbase = (long)b * SEQ;
        win_load(W, P, rowbase + 128 * (jb - 1), 1, OIN, O_K + 64 * kvh, O_V + 64 * kvh, jb > 0, th, true);
        const long qtok = rowbase + 128 * jb + 32 * wq + (lane & 31);
        band_prefetch(pre, P + (size_t)qtok * OIN + O_Q + 64 * (8 * kvh), lutg + (8 * kvh) * LUTP, 1, 127, lane); }
    {   const int u = vcu;
        const int sub = 2 * u + half;
        const int jb = sub & 15, kvh = (sub >> 4) & 1, b = sub >> 5;
        const long rowbase = (long)b * SEQ;
        win_store(W, hb + BAND_K, hb + BAND_V, th);
        __syncthreads();
        const long qtok = rowbase + 128 * jb + 32 * wq + (lane & 31);
        for (int j = 0; j < 8; ++j) {
            const int h = 8 * kvh + j;
            const BandPre cur = pre;
            { const int hn = (j < 7) ? h + 1 : h; band_prefetch(pre, P + (size_t)qtok * OIN + O_Q + 64 * hn, lutg + hn * LUTP, 1, 127, lane); }
            BandTask T; T.orow = O + (size_t)qtok * DM + 64 * h; T.lsep = nullptr; T.mode = 3; T.sink2 = a.swa_sinks[h] * LOG2E; T.qsub = wq; T.has_prev = jb > 0; T.flip = 0;
            band_task(T, cur, hb + BAND_K, hb + BAND_V, (LAS float*)(hb + BAND_LUT + wq * 768), lane);
        }
        __syncthreads();
    }
}

constexpr int SC_PITCH = 2308;
static_assert(16 * SC_PITCH * 4 <= LDS_SCR, "score LDS");
__device__ __forceinline__ unsigned f2key(float f) { const unsigned u = __builtin_bit_cast(unsigned, f + 0.0f); return (u & 0x80000000u) ? ~u : (u | 0x80000000u); }
__device__ __forceinline__ void transpose32(unsigned (&x)[32]) {
#define TR_STAGE(D, MD) _Pragma("unroll") for (int i = 0; i < 32; ++i) if (!(i & (D))) { const unsigned a_ = x[i], b_ = x[i + (D)]; \
        x[i] = (a_ & ~(MD)) | ((b_ << (D)) & (MD)); x[i + (D)] = (b_ & (MD)) | ((a_ >> (D)) & ~(MD)); }
    TR_STAGE(16, 0xFFFF0000u) TR_STAGE(8, 0xFF00FF00u) TR_STAGE(4, 0xF0F0F0F0u) TR_STAGE(2, 0xCCCCCCCCu) TR_STAGE(1, 0xAAAAAAAAu)
#undef TR_STAGE
}
__device__ __forceinline__ unsigned bits_shuffle(unsigned x) {
    unsigned t;
    t = (x ^ (x >> 8)) & 0x0000FF00u; x ^= t ^ (t << 8); t = (x ^ (x >> 4)) & 0x00F000F0u; x ^= t ^ (t << 4);
    t = (x ^ (x >> 2)) & 0x0C0C0C0Cu; x ^= t ^ (t << 2); t = (x ^ (x >> 1)) & 0x22222222u; x ^= t ^ (t << 1);
    return x;
}
__device__ __forceinline__ unsigned bits_unshuffle(unsigned x) {
    unsigned t;
    t = (x ^ (x >> 1)) & 0x22222222u; x ^= t ^ (t << 1); t = (x ^ (x >> 2)) & 0x0C0C0C0Cu; x ^= t ^ (t << 2);
    t = (x ^ (x >> 4)) & 0x00F000F0u; x ^= t ^ (t << 4); t = (x ^ (x >> 8)) & 0x0000FF00u; x ^= t ^ (t << 8);
    return x;
}
__device__ __forceinline__ unsigned tie_lowest(unsigned alive, int need, int lane) {
    const int c = __popc(alive);
    int inc = c;
    inc += __builtin_amdgcn_update_dpp(0, inc, 0x111, 0xf, 0xf, true); inc += __builtin_amdgcn_update_dpp(0, inc, 0x112, 0xf, 0xf, true);
    inc += __builtin_amdgcn_update_dpp(0, inc, 0x114, 0xf, 0xf, true); inc += __builtin_amdgcn_update_dpp(0, inc, 0x118, 0xf, 0xf, true);
    const int t0 = __builtin_amdgcn_readlane(inc, 15), t1 = __builtin_amdgcn_readlane(inc, 31), t2 = __builtin_amdgcn_readlane(inc, 47);
    const int row = lane >> 4;
    const int pre = inc - c + (row >= 1 ? t0 : 0) + (row >= 2 ? t1 : 0) + (row >= 3 ? t2 : 0);
    const int r = need - pre;
    if (r <= 0) return 0u;
    if (r >= c) return alive;
    const unsigned wk = bits_shuffle(alive); int lo = 0;
#pragma unroll
    for (int step = 16; step >= 1; step >>= 1) { const int t = lo + step; if (__popc(wk & ((1u << t) - 1u)) < r) lo = t; }
    return bits_unshuffle(wk & ((2u << lo) - 1u));
}
__device__ __forceinline__ float relu1(float x) { return __builtin_amdgcn_fmed3f(x, 0.0f, 3.0e38f); }
__device__ __forceinline__ float key2f(unsigned k) { const unsigned u = (k & 0x80000000u) ? (k ^ 0x80000000u) : ~k; return __builtin_bit_cast(float, u); }
struct SelOps { h16x8 qi[8]; h16x8 w8; h16x8 kf[16]; };
__device__ __forceinline__ void sel_load(SelOps& S, const h16* P, const h16* QB, long rowb, int qt, int wave, int q16, int g4) {
    const int t0 = 16 * qt;
    const h16* qrow = QB + (size_t)(rowb + t0 + q16) * QBW + 512 + 8 * g4;
#pragma unroll
    for (int h = 0; h < 8; ++h) S.qi[h] = *(const h16x8*)(qrow + 32 * h);
    S.w8 = *(const h16x8*)(P + (size_t)(rowb + t0 + q16) * PJP + PJ_WI);
    const h16* kbase = P + (size_t)(rowb + q16) * PJP + PJ_KI + 8 * g4;
#pragma unroll
    for (int z = 0; z < 16; ++z) { const int kt = wave + 8 * z; if (kt <= qt) S.kf[z] = *(const h16x8*)(kbase + (size_t)(16 * kt) * PJP); }
}
__device__ __forceinline__ void phase_select(const Args& a, unsigned char* ws, LAS unsigned char* lds, int vcu, int G, int tid, int wave, int lane) {
    const h16* P = big_view(ws, vcu >> 5, PJP); const h16* QB = (const h16*)(ws + WS_QB); unsigned* BMP = (unsigned*)(ws + WS_BM);
    LAS unsigned* sc = (LAS unsigned*)lds;
    const int q16 = lane & 15, g4 = lane >> 4;
    const int b = vcu >> 4, j = vcu & 15; const long rowb = (long)b * SEQ;
    SelOps ops; sel_load(ops, P, QB, rowb, j, wave, q16, g4);
    for (int i = 0; i < 8; ++i) {
        {
            const int qt = (i & 1) ? (32 * (i >> 1) + 31 - j) : (32 * (i >> 1) + j);
            const int t0 = 16 * qt;
            { float wv[8];
#pragma unroll
              for (int h = 0; h < 8; ++h) wv[h] = (float)ops.w8[h];
#pragma unroll
              for (int z = 0; z < 16; ++z) { const int kt = wave + 8 * z;
                  if (kt <= qt) {
                      f32x4 sacc = {0.f, 0.f, 0.f, 0.f}; f32x4 dh[8];
#pragma unroll
                      for (int h = 0; h < 8; ++h) { const f32x4 zz = {0.f, 0.f, 0.f, 0.f}; dh[h] = __builtin_amdgcn_mfma_f32_16x16x32_f16(ops.kf[z], ops.qi[h], zz, 0, 0, 0); }
#pragma unroll
                      for (int h = 0; h < 8; ++h)
#pragma unroll
                          for (int e = 0; e < 4; ++e) sacc[e] += wv[h] * relu1(dh[h][e]);
                      u32x4 kk; kk.x = f2key(sacc[0]); kk.y = f2key(sacc[1]); kk.z = f2key(sacc[2]); kk.w = f2key(sacc[3]);
                      *(LAS u32x4*)(sc + q16 * SC_PITCH + 16 * kt + 4 * g4 + 4 * (kt >> 1)) = kk;
                  } } }
            if (i < 7) { const int qn = ((i + 1) & 1) ? (32 * ((i + 1) >> 1) + 31 - j) : (32 * ((i + 1) >> 1) + j); sel_load(ops, P, QB, rowb, qn, wave, q16, g4); }
            __syncthreads();
            {
                const int rowA = 2 * wave, tA = t0 + rowA, tB = tA + 1;
                int nvA = tA - 32 * lane + 1; nvA = nvA < 0 ? 0 : (nvA > 32 ? 32 : nvA); int nvB = tB - 32 * lane + 1; nvB = nvB < 0 ? 0 : (nvB > 32 ? 32 : nvB);
                const unsigned admA = ((1u << ((nvA + 1) >> 1)) - 1u) | (((1u << (nvA >> 1)) - 1u) << 16);
                const unsigned admB = ((1u << ((nvB + 1) >> 1)) - 1u) | (((1u << (nvB >> 1)) - 1u) << 16);
                unsigned selA = admA, selB = admB;
                if (tB >= 256) {
                    unsigned ka[32], kb[32];
#pragma unroll
                    for (int i8 = 0; i8 < 8; ++i8) { const u32x4 va = *(const LAS u32x4*)(sc + rowA * SC_PITCH + 36 * lane + 4 * i8); const u32x4 vb = *(const LAS u32x4*)(sc + (rowA + 1) * SC_PITCH + 36 * lane + 4 * i8);
#pragma unroll
                        for (int e = 0; e < 4; ++e) { ka[16 * (e & 1) + 2 * i8 + (e >> 1)] = va[e]; kb[16 * (e & 1) + 2 * i8 + (e >> 1)] = vb[e]; } }
                    transpose32(ka); transpose32(kb);
                    unsigned alA = admA, alB = admB; selA = 0u; selB = 0u;
                    int needA = 256, needB = 256; int doneA = 0, doneB = 0;
#pragma unroll
                    for (int bb = 31; bb >= 0; --bb) {
                        const unsigned oa = alA & ka[bb], ob = alB & kb[bb];
                        int c = __popc(oa) + (__popc(ob) << 16);
                        c += __builtin_amdgcn_update_dpp(0, c, 0x111, 0xf, 0xf, true); c += __builtin_amdgcn_update_dpp(0, c, 0x112, 0xf, 0xf, true);
                        c += __builtin_amdgcn_update_dpp(0, c, 0x114, 0xf, 0xf, true); c += __builtin_amdgcn_update_dpp(0, c, 0x118, 0xf, 0xf, true);
                        const unsigned tot = (unsigned)(__builtin_amdgcn_readlane(c, 15) + __builtin_amdgcn_readlane(c, 31) + __builtin_amdgcn_readlane(c, 47) + __builtin_amdgcn_readlane(c, 63));
                        const int nA = (int)(tot & 0xFFFFu), nB = (int)(tot >> 16);
                        { const unsigned ge = (unsigned)(nA >= needA), eq = (unsigned)(nA == needA); const unsigned mNT = ge - 1u, mKeep = eq - 1u;
                          selA |= oa & (mNT | ~mKeep); alA = alA & (ka[bb] ^ mNT) & mKeep; needA -= (int)(mNT & (unsigned)nA); doneA |= (int)eq; }
                        { const unsigned ge = (unsigned)(nB >= needB), eq = (unsigned)(nB == needB); const unsigned mNT = ge - 1u, mKeep = eq - 1u;
                          selB |= ob & (mNT | ~mKeep); alB = alB & (kb[bb] ^ mNT) & mKeep; needB -= (int)(mNT & (unsigned)nB); doneB |= (int)eq; }
                        if (doneA & doneB) break;
                    }
                    if (!doneA) selA |= tie_lowest(alA, needA, lane);
                    if (!doneB) selB |= tie_lowest(alB, needB, lane);
                }
                unsigned* bmA = BMP + (size_t)(rowb + tA) * 64;
                bmA[lane] = selA; bmA[64 + lane] = selB;
            }
            __syncthreads();
        }
    }
}

constexpr int B2_K = 0, B2_V = 2 * KVImg<128>::KBYTES, B2_LUT = B2_V + 2 * KVImg<128>::VBYTES, B2_END = B2_LUT + 2080 * 4;
static_assert(B2_END <= LDS_SCR, "B2 LDS");
__device__ __forceinline__ void phase_dsa(const Args& a, unsigned char* ws, LAS unsigned char* lds, int vcu, int G, int tid, int wave, int lane) {
    const h16* QB = (const h16*)(ws + WS_QB); const unsigned* BMP = (const unsigned*)(ws + WS_BM);
    h16* O = (h16*)(ws + WS_O); const float* lutg = (const float*)(ws + WS_LUT); const u64* sscq = (const u64*)(ws + WS_SS) + 7 * (size_t)M;
    LAS float* lut = (LAS float*)(lds + B2_LUT);
    const int r32 = lane & 31, hi = lane >> 5;
    for (int i = 0; i < 4; ++i)
        {
            const int grp_ = vcu >> 5, rnk_ = vcu & 31; const int bhl = 4 * i + (rnk_ >> 3), j8 = rnk_ & 7;
            const int b = 2 * grp_ + (bhl >> 3), h = bhl & 7;
            const int qb = (i == 0) ? j8 : (i == 1) ? 7 - j8 : (i == 2) ? ((j8 + 4) & 7) : 7 - ((j8 + 4) & 7);
            const long rowb = (long)b * SEQ; const int q0w = 256 * qb + 32 * wave; const int tq = q0w + r32; const long qtok = rowb + tq;
            for (int x = tid; x < 2080; x += NTHREADS) lut[x] = (x >= 32) ? lutg[(8 + h) * LUTP + x - 32] : 0.f;
            h16x8 qf[4];
#pragma unroll
            for (int ks = 0; ks < 4; ++ks) qf[ks] = *(const h16x8*)(QB + (size_t)qtok * QBW + 64 * h + ks * 16 + hi * 8);
            const float scl = __builtin_amdgcn_rsqf(ss_val(sscq[qtok]) * (1.0f / 256.0f) + EPS) * QSCALE2;
            const int nch = 2 * qb + 2;
            const h16* P = kv_rows(ws, vcu >> 5, T_KB, b, h);
            fill_kv<128>(lds + B2_K, lds + B2_V, P, rowb, 1, 64, 0, KV_TS, 0, 128, tid, NTHREADS);
            __syncthreads();
#pragma unroll
            for (int ks = 0; ks < 4; ++ks)
#pragma unroll
                for (int e = 0; e < 8; e += 2) { const unsigned w = pkh((float)qf[ks][e] * scl, (float)qf[ks][e + 1] * scl); const h16x2 hh = __builtin_bit_cast(h16x2, w); qf[ks][e] = hh[0]; qf[ks][e + 1] = hh[1]; }
            float mref = 0.f, lrun = 0.f; f32x16 o[2]; o[0] = f32x16{}; o[1] = f32x16{}; bool first = true;
            const int laneb = r32 - 4 * hi + 5;
            u32x4 bwn = *(const u32x4*)(BMP + (size_t)qtok * 64);
            for (int c = 0; c < nch; ++c) {
                const LAS unsigned char* Kimg = lds + B2_K + (c & 1) * KVImg<128>::KBYTES; const LAS unsigned char* Vimg = lds + B2_V + (c & 1) * KVImg<128>::VBYTES;
                u32x4 pk[2], pv[2];
                const bool more = c + 1 < nch;
                if (more) {
#pragma unroll
                    for (int z = 0; z < 2; ++z) { const int p = tid + z * NTHREADS; const int row = p >> 3, cc = p & 7; const h16* g = P + (size_t)(rowb + 128 * (c + 1) + row) * 64 + cc * 8;
                        pk[z] = *(const u32x4*)g; pv[z] = *(const u32x4*)(g + KV_TS); }
                }
                const u32x4 bw = bwn; if (more) bwn = *(const u32x4*)(BMP + (size_t)qtok * 64 + 4 * (c + 1));
                const LAS float* lp0 = lut + laneb + (q0w - 128 * c);
                const LAS unsigned char* kp0 = Kimg + hi * KVImg<128>::KCH + r32 * 16;
                float lv[16]; h16x8 kf[4];
#pragma unroll
                for (int r = 0; r < 16; ++r) lv[r] = lp0[27 - crow_c(r)];
#pragma unroll
                for (int ks = 0; ks < 4; ++ks) kf[ks] = *(const LAS h16x8*)(kp0 + 2 * ks * KVImg<128>::KCH);
#pragma unroll
                for (int j = 0; j < 4; ++j) {
                    const int k0 = 128 * c + 32 * j;
                    if (k0 <= q0w) {
                        f32x16 acc;
#pragma unroll
                        for (int r = 0; r < 16; ++r) acc[r] = lv[r] - mref;
#pragma unroll
                        for (int ks = 0; ks < 4; ++ks) acc = __builtin_amdgcn_mfma_f32_32x32x16_f16(kf[ks], qf[ks], acc, 0, 0, 0);
                        if (j < 3) {
#pragma unroll
                            for (int r = 0; r < 16; ++r) lv[r] = lp0[27 - 32 * (j + 1) - crow_c(r)];
#pragma unroll
                            for (int ks = 0; ks < 4; ++ks) kf[ks] = *(const LAS h16x8*)(kp0 + 512 * (j + 1) + 2 * ks * KVImg<128>::KCH);
                        }
                        h16x4 vlo[2][2], vhi[2][2];
                        { const LAS unsigned char* vp = Vimg + (32 * j + 4 * hi + ((lane & 15) >> 2)) * 64 + ((lane >> 4) & 1) * 32 + (lane & 3) * 8;
#pragma unroll
                          for (int sx = 0; sx < 2; ++sx)
#pragma unroll
                              for (int d0 = 0; d0 < 2; ++d0) { vlo[sx][d0] = vtr(vp + d0 * KVImg<128>::VDH + sx * 1024); vhi[sx][d0] = vtr(vp + d0 * KVImg<128>::VDH + sx * 1024 + 512); } }
                        const s16x2 wsh = __builtin_bit_cast(s16x2, bw[j] >> (2 * hi));
                        f32x16 s = acc; float mx = -INFINITY;
#pragma unroll
                        for (int r = 0; r < 16; ++r) mx = fmaxf(mx, s[r]);
                        mx = xhalf_max(mx);
                        if (first || __any(mx > 8.0f)) {
                            const float dl = first ? mx : fmaxf(mx, 0.f); first = false;
                            mref += dl; const float alpha = ex2(-dl); lrun *= alpha;
#pragma unroll
                            for (int r = 0; r < 16; ++r) { s[r] -= dl; o[0][r] *= alpha; o[1][r] *= alpha; }
                        }
                        float ls = 0.f; unsigned pp[8];
                        const h16x2 ones2 = {(h16)1.0f, (h16)1.0f};
#pragma unroll
                        for (int pr = 0; pr < 8; ++pr) {
                            const unsigned pw = pkh(ex2(s[2 * pr]), ex2(s[2 * pr + 1]));
                            const s16x2 mk = (wsh << (short)(15 - (4 * (pr >> 1) + (pr & 1)))) >> (short)15;
                            const unsigned pm = pw & __builtin_bit_cast(unsigned, mk);
                            pp[pr] = pm; ls = __builtin_amdgcn_fdot2(__builtin_bit_cast(h16x2, pm), ones2, ls, false);
                        }
                        lrun += ls;
#pragma unroll
                        for (int sx = 0; sx < 2; ++sx) {
                            const u32x4 pw4 = {pp[4 * sx + 0], pp[4 * sx + 1], pp[4 * sx + 2], pp[4 * sx + 3]};
                            const h16x8 pf = __builtin_bit_cast(h16x8, pw4);
#pragma unroll
                            for (int d0 = 0; d0 < 2; ++d0) {
                                const h16x8 vf = {vlo[sx][d0][0], vlo[sx][d0][1], vlo[sx][d0][2], vlo[sx][d0][3], vhi[sx][d0][0], vhi[sx][d0][1], vhi[sx][d0][2], vhi[sx][d0][3]};
                                o[d0] = __builtin_amdgcn_mfma_f32_32x32x16_f16(vf, pf, o[d0], 0, 0, 0);
                            }
                        }
                    }
                }
                if (more) {
                    LAS unsigned char* Kn = lds + B2_K + ((c + 1) & 1) * KVImg<128>::KBYTES; LAS unsigned char* Vn = lds + B2_V + ((c + 1) & 1) * KVImg<128>::VBYTES;
#pragma unroll
                    for (int z = 0; z < 2; ++z) { const int p = tid + z * NTHREADS; const int row = p >> 3, cc = p & 7;
                        *(LAS u32x4*)(Kn + cc * KVImg<128>::KCH + row * 16) = pk[z]; *(LAS u32x4*)(Vn + (cc >> 2) * KVImg<128>::VDH + row * 64 + (cc & 3) * 16) = pv[z]; }
                }
                __syncthreads();
            }
            const float inv = 1.0f / xhalf_sum(lrun);
            h16* orow = O + (size_t)qtok * DM + 512 + 64 * h;
#pragma unroll
            for (int d0 = 0; d0 < 2; ++d0)
#pragma unroll
                for (int g4 = 0; g4 < 4; ++g4) { u32x2 w; w.x = pkb(o[d0][4 * g4 + 0] * inv, o[d0][4 * g4 + 1] * inv); w.y = pkb(o[d0][4 * g4 + 2] * inv, o[d0][4 * g4 + 3] * inv);
                    *(u32x2*)(orow + 32 * d0 + 8 * g4 + 4 * hi) = w; }
        }
}

__global__ void __launch_bounds__(NTHREADS, 2) fwd_kernel(Args args) {
    extern __shared__ __attribute__((aligned(16))) unsigned char lds_raw[];
    {   LAS unsigned char* lds0 = (LAS unsigned char*)lds_raw;
        for (int u = threadIdx.x; u < (LDS_BYTES - LDSCTL_OFF) / 4; u += NTHREADS) ((LAS unsigned*)(lds0 + LDSCTL_OFF))[u] = 0u;
        __syncthreads();
        if (!MK_PER_PHASE) { xcd_barrier_post((unsigned*)((gu32*)(args.ws + WS_CTL) + CW_BAR)); xcd_barrier_post((unsigned*)((gu32*)(args.ws + WS_CTL) + CW_BAR) + (1 + (blockIdx.x & 7)) * XCD_BAR_WORDS); }
    }
    const int lo = args.ph_lo, hi = args.ph_hi;
    int ph = 0;
#define PH_BEGIN(kind) if (ph >= lo && ph < hi) { const int kind_ = (kind); (void)kind_; const unsigned long long pt0_ = MK_PROBE ? __builtin_amdgcn_s_memrealtime() : 0ull; \
        int tid = threadIdx.x; asm volatile("" : "+v"(tid)); const int lane = tid & 63, wave = __builtin_amdgcn_readfirstlane(tid >> 6); \
        GAS unsigned char* wsg_ = (GAS unsigned char*)args.ws; asm volatile("" : "+s"(wsg_)); unsigned char* ws = (unsigned char*)wsg_; \
        LAS unsigned char* lds = (LAS unsigned char*)lds_raw; \
        const int G = gridDim.x, bx = blockIdx.x; const int grp = bx & 7, rnk = bx >> 3; const int vcu = 32 * grp + rnk; (void)rnk; \
        h16* wb = (h16*)(ws + WS_W); h16* XN = (h16*)(ws + WS_XN); h16* OB = (h16*)(ws + WS_O); h16* QBB = (h16*)(ws + WS_QB); u64* SS = (u64*)(ws + WS_SS); \
        (void)lane; (void)wave; (void)vcu; (void)wb; (void)XN; (void)OB; (void)QBB; (void)SS; (void)lds;
#define PH_END   if (!MK_PER_PHASE && ph + 1 < hi) { unsigned* bar0_ = (unsigned*)((gu32*)(ws + WS_CTL) + CW_BAR); \
            if (ph == 0) xcd_barrier<false>(bar0_, (volatile LAS unsigned*)(lds + MISC_OFF) + 8, (unsigned)G); \
            else xcd_barrier<true>(bar0_ + (1 + grp) * XCD_BAR_WORDS, (volatile LAS unsigned*)(lds + MISC_OFF) + 10, (unsigned)(G >> 3)); } \
        if (MK_PROBE && ((MK_PROBE >> kind_) & 1)) { const unsigned long long pt1_ = __builtin_amdgcn_s_memrealtime(); while (__builtin_amdgcn_s_memrealtime() < pt1_ + (pt1_ - pt0_)) __builtin_amdgcn_s_sleep(8); } } ++ph;

    PH_BEGIN(0)
        if (MK_ONLY & 1) prologue(args, ws, lds, vcu * NWAVES + wave, G * NWAVES, wave, lane);
    PH_END

    for (int step = 0; step < 4; ++step) {
        const int l = step >> 1, j = step & 1;
        const int ssi = (l == 0) ? (j == 0 ? 0 : 2) : (j == 0 ? 3 : 5);
        PH_BEGIN(1)
            pg8::Gemm g{XN, wb + (WO_W13 + (size_t)(2 * l + j) * W13_BYTES) / 2, DM, DM, DM}; pg8::StaticOrder S; S.init(2 * FF, grp, rnk);
            pg8::EpiSwiGLU E{big_view(ws, grp, FF), FF, pg8::stage_rinv(lds, SS + (size_t)ssi * M, 4096 * grp, tid), 4096 * grp};
            if (MK_ONLY & 2) pg8::gemm_phase<pg8::EpiSwiGLU, true>(lds, tid, g, S, E);
        PH_END
        PH_BEGIN(2)
            pg8::Gemm g{big_view(ws, grp, FF), wb + (WO_W2 + (size_t)(2 * l + j) * W2_BYTES) / 2, FF, FF, FF}; pg8::StaticOrder S; S.init(DM, grp, rnk);
            pg8::EpiResid E{XN, SS + (size_t)(ssi + 1) * M, 0.5f};
            if (MK_ONLY & 4) pg8::gemm_phase<pg8::EpiResid, true>(lds, tid, g, S, E);
        PH_END
        if (j == 0) {
            const int ssm = ssi + 1;
            PH_BEGIN((l == 0 ? 3 : 11))
                if (!((l == 0 && (MK_SKIP & 8)) || (l == 1 && (MK_SKIP & 16)))) {
                pg8::Gemm g{XN, wb + (l == 0 ? WO_WINE : WO_WINO) / 2, DM, DM, DM}; pg8::StaticOrder S; S.init(l == 0 ? EINP : OIN, grp, rnk);
                pg8::EpiH16 E{big_view(ws, grp, l == 0 ? PJP : OIN), l == 0 ? PJP : OIN, pg8::stage_rinv(lds, SS + (size_t)ssm * M, 4096 * grp, tid), 4096 * grp, l == 0 ? SS + (size_t)7 * M : nullptr, E_CQ_TILE, l == 0 ? kv_base(ws, grp) : nullptr};
                if (MK_ONLY & 8) pg8::gemm_phase<pg8::EpiH16, true>(lds, tid, g, S, E);
                }
            PH_END
            if (l == 0) {
                for (int br = 0; br < 3; ++br) {
                    PH_BEGIN((5 + br))
                        if ((grp & 1) && (MK_ONLY & 32) && !(MK_SKIP & (8 | 1))) phase_band_A(args, ws, lds, vcu, G, tid, wave, lane, br == 0 ? 16 : (br == 1 ? 4 : 1), br);
                        if (!(MK_SKIP & (8 | 2))) {
                            int tid = threadIdx.x; asm volatile("" : "+v"(tid)); const int lane = tid & 63, wave = __builtin_amdgcn_readfirstlane(tid >> 6);
                            if (br == 0) {
                                int kq = 256; asm volatile("" : "+s"(kq));
                                pg8::Gemm g{big_view(ws, grp, PJP) + PJ_CQ, wb + WO_WQ / 2, PJP, 256, kq}; pg8::StaticOrder S; S.init(QBW, grp, rnk);
                                pg8::EpiPlainH16 E{QBB, QBW};
                                if (MK_ONLY & 16) pg8::gemm_phase<pg8::EpiPlainH16, true>(lds, tid, g, S, E);
                            } else if (br == 1) { if (MK_ONLY & 64) phase_select(args, ws, lds, vcu, G, tid, wave, lane); }
                            else { if (MK_ONLY & 128) phase_dsa(args, ws, lds, vcu, G, tid, wave, lane); }
                        }
                        if (!(grp & 1) && (MK_ONLY & 32) && !(MK_SKIP & (8 | 1))) {
                            int tid = threadIdx.x; asm volatile("" : "+v"(tid)); const int lane = tid & 63, wave = __builtin_amdgcn_readfirstlane(tid >> 6);
                            phase_band_A(args, ws, lds, vcu, G, tid, wave, lane, br == 0 ? 16 : (br == 1 ? 4 : 1), br); }
                    PH_END
                }
            } else {
                PH_BEGIN(12)
                    if ((MK_ONLY & 256) && !(MK_SKIP & (16 | 4))) phase_band_C(args, ws, lds, vcu, G, tid, wave, lane);
                PH_END
            }
            PH_BEGIN((l == 0 ? 10 : 13))
                pg8::Gemm g{OB, wb + (l == 0 ? WO_WOUTE : WO_WOUTO) / 2, DM, DM, DM}; pg8::StaticOrder S; S.init(DM, grp, rnk);
                const bool skip = (l == 0 && (MK_SKIP & 8)) || (l == 1 && (MK_SKIP & 16));
                pg8::EpiResid E{XN, SS + (size_t)(ssm + 1) * M, skip ? 0.0f : 1.0f};
                if (MK_ONLY & 512) pg8::gemm_phase<pg8::EpiResid, true>(lds, tid, g, S, E);
            PH_END
        }
    }
    PH_BEGIN(14)
        const u64* ss6 = SS + (size_t)6 * M; const int NGW = 32 * NWAVES; const int mbeg = 4096 * grp + rnk * NWAVES + wave, mend = 4096 * grp + 4096;
        if (MK_ONLY & 1024) for (int m0 = mbeg; m0 < mend; m0 += 4 * NGW) {
            h16x8 hv[4][2]; float rinv[4];
#pragma unroll
            for (int r = 0; r < 4; ++r) { const int m = m0 + r * NGW; if (m < mend) { const h16x8* hr = (const h16x8*)(XN + (size_t)m * DM) + lane; hv[r][0] = hr[0]; hv[r][1] = hr[64]; rinv[r] = ss_val(ss6[m]); } }
            const f32x4* gr = (const f32x4*)args.final_g + 2 * lane; const f32x4 g00 = gr[0], g01 = gr[1], g10 = gr[128], g11 = gr[129];
#pragma unroll
            for (int r = 0; r < 4; ++r) { const int m = m0 + r * NGW; if (m < mend) { const float ri = __builtin_amdgcn_rsqf(rinv[r] * (1.0f / DM) + EPS); f32x4* xr = (f32x4*)(args.out + (size_t)m * DM) + 2 * lane;
#pragma unroll
                for (int jj = 0; jj < 2; ++jj) { const u32x4 v = __builtin_bit_cast(u32x4, hv[r][jj]);
                    xr[128 * jj] = (f32x4){bflo(v[0]), bfhi(v[0]), bflo(v[1]), bfhi(v[1])} * ri * (jj ? g10 : g00); xr[128 * jj + 1] = (f32x4){bflo(v[2]), bfhi(v[2]), bflo(v[3]), bfhi(v[3])} * ri * (jj ? g11 : g01); } } }
        }
    PH_END
#undef PH_BEGIN
#undef PH_END
}
constexpr int N_PHASES = 1 + 4 * 2 + (1 + 3 + 1) + (1 + 1 + 1) + 1;

extern "C" void kernel_launch(void* const* d_in, const int* in_sizes, int n_in, void* d_out, int out_size, void* d_ws, size_t ws_size, hipStream_t stream) {
    static int grid = 0;
    if (grid == 0) {
        if (n_in != 15 || in_sizes[0] != M * DM || out_size != M * DM || ws_size < WS_END) { fprintf(stderr, "kernel_launch: unexpected shapes / workspace (%d inputs, ws %zu)\n", n_in, ws_size); grid = -1; return; }
        int dev = 0, cus = 0, per_cu = 0;
        if (hipGetDevice(&dev) != hipSuccess || hipDeviceGetAttribute(&cus, hipDeviceAttributeMultiprocessorCount, dev) != hipSuccess) { grid = -1; return; }
        if (hipFuncSetAttribute((const void*)fwd_kernel, hipFuncAttributeMaxDynamicSharedMemorySize, LDS_BYTES) != hipSuccess) { fprintf(stderr, "kernel_launch: hipFuncSetAttribute failed\n"); grid = -1; return; }
        if (hipOccupancyMaxActiveBlocksPerMultiprocessor(&per_cu, (const void*)fwd_kernel, NTHREADS, LDS_BYTES) != hipSuccess || per_cu < 1) { fprintf(stderr, "kernel_launch: occupancy query says %d\n", per_cu); }
        (void)hipGetLastError();
        grid = 256; (void)cus;
    }
    if (grid < 0) return;
    if (hipMemsetAsync((char*)d_ws + WS_CTL, 0, CTL_ZERO_BYTES, stream) != hipSuccess) return;
    Args a{};
    a.x = (const float*)d_in[0]; a.norm_g = (const float*)d_in[1]; a.final_g = (const float*)d_in[2]; a.table = (const float*)d_in[3];
    a.w1 = (const float*)d_in[4]; a.w3 = (const float*)d_in[5]; a.w2 = (const float*)d_in[6];
    a.hyb_w_in = (const float*)d_in[7]; a.hyb_cq_g = (const float*)d_in[8]; a.hyb_wq_b = (const float*)d_in[9]; a.hyb_wq_idx = (const float*)d_in[10]; a.hyb_w_out = (const float*)d_in[11];
    a.swa_w_in = (const float*)d_in[12]; a.swa_sinks = (const float*)d_in[13]; a.swa_w_out = (const float*)d_in[14];
    a.out = (float*)d_out; a.ws = (unsigned char*)d_ws;
#if MK_PER_PHASE
    for (int p = 0; p < N_PHASES; ++p) { a.ph_lo = p; a.ph_hi = p + 1; hipLaunchKernelGGL(fwd_kernel, dim3(grid), dim3(NTHREADS), LDS_BYTES, stream, a); }
#else
    a.ph_lo = 0; a.ph_hi = N_PHASES;
    hipLaunchKernelGGL(fwd_kernel, dim3(grid), dim3(NTHREADS), LDS_BYTES, stream, a);
#endif
}
```

```cpp
#include <hip/hip_runtime.h>
#include <cstdio>
#include <cstdint>

#define LAS __attribute__((address_space(3)))
#define GAS __attribute__((address_space(1)))
typedef _Float16 h16;
typedef _Float16 h16x8 __attribute__((ext_vector_type(8)));
typedef _Float16 h16x4 __attribute__((ext_vector_type(4)));
typedef _Float16 h16x2 __attribute__((ext_vector_type(2)));
typedef short s16x2 __attribute__((ext_vector_type(2)));
typedef float f32x2 __attribute__((ext_vector_type(2)));
typedef float f32x4 __attribute__((ext_vector_type(4)));
typedef float f32x16 __attribute__((ext_vector_type(16)));
typedef unsigned u32x2 __attribute__((ext_vector_type(2)));
typedef unsigned u32x4 __attribute__((ext_vector_type(4)));
typedef short v4i16_t __attribute__((ext_vector_type(4)));
typedef GAS unsigned gu32;

#ifndef MK_PER_PHASE
#define MK_PER_PHASE 0
#endif
#ifndef MK_ONLY
#define MK_ONLY 0xFFFF
#endif
#ifndef MK_PROBE
#define MK_PROBE 0
#endif
#ifndef MK_SKIP
#define MK_SKIP 0
#endif

constexpr int NB = 16, SEQ = 2048, DM = 1024, FF = 2816, M = NB * SEQ;
constexpr int EIN = 2856, EINP = 3072, OIN = 1280, QBW = 768;
constexpr int E_CQ_TILE = 6;
constexpr int PJP = 1024, PJ_QA = 0, PJ_CQ = 512, PJ_KI = 768, PJ_WI = 800;
constexpr int KV_TS = 2 * 8 * 2048 * 64;
constexpr int T_KA = 0, T_VA = 1, T_KB = 2, T_VB = 3;
constexpr int O_Q = 0, O_K = 1024, O_V = 1152;
constexpr float EPS = 1e-6f;
constexpr float LOG2E = 1.4426950408889634f;
constexpr float QSCALE2 = 0.125f * LOG2E;
constexpr int LUTP = 2112;

constexpr size_t MiB = 1u << 20;
constexpr size_t WS_CTL = 0, CTL_ZERO_BYTES = 3 * MiB;
constexpr size_t WS_SS = 1 * MiB;
typedef unsigned long long u64;
constexpr float SS_FIX = 16777216.0f, SS_UNFIX = 1.0f / 16777216.0f;
__device__ __forceinline__ u64 ss_fix(float s) { return (u64)(s * SS_FIX + 0.5f); }
__device__ __forceinline__ float ss_val(u64 v) { return (float)v * SS_UNFIX; }
constexpr size_t WS_LUT = 3 * MiB;
constexpr size_t WS_LSE = 3 * MiB + 512 * 1024;
constexpr size_t WS_W = 5 * MiB;
constexpr size_t W13_BYTES = (size_t)2 * FF * DM * 2, W2_BYTES = (size_t)DM * FF * 2;
constexpr size_t WO_W13 = 0, WO_W2 = WO_W13 + 4 * W13_BYTES, WO_WINE = WO_W2 + 4 * W2_BYTES, WO_WQ = WO_WINE + (size_t)EINP * DM * 2,
                 WO_WOUTE = WO_WQ + (size_t)QBW * 256 * 2, WO_WINO = WO_WOUTE + (size_t)DM * DM * 2, WO_WOUTO = WO_WINO + (size_t)OIN * DM * 2, WO_END = WO_WOUTO + (size_t)DM * DM * 2;
static_assert(WO_END <= 79 * MiB && 16 * LUTP * 4 <= 512 * 1024 && WS_LSE + (size_t)32768 * 8 * 4 <= WS_W, "low workspace map");
constexpr size_t WS_XN = 84 * MiB, WS_BIG = 148 * MiB, WS_O = 340 * MiB, WS_QB = 404 * MiB, WS_BM = 452 * MiB, WS_END = 460 * MiB;
static_assert(WS_XN + (size_t)M * DM * 2 <= WS_BIG && WS_BIG + (size_t)M * EINP * 2 <= WS_O && WS_O + (size_t)M * DM * 2 <= WS_QB && WS_QB + (size_t)M * QBW * 2 <= WS_BM && WS_BM + (size_t)M * 64 * 4 <= WS_END, "ws map");
constexpr int CW_TMO = 0, CW_BAR = 4096;

constexpr size_t BIG_SLAB = (size_t)4096 * EINP * 2;
__device__ __forceinline__ h16* big_view(unsigned char* ws, int grp, int pitch) { return (h16*)(ws + WS_BIG + (size_t)grp * BIG_SLAB) - (size_t)4096 * grp * pitch; }
__device__ __forceinline__ h16* kv_base(unsigned char* ws, int grp) { return (h16*)(ws + WS_BIG + (size_t)grp * BIG_SLAB + (size_t)4096 * PJP * 2); }
__device__ __forceinline__ h16* kv_rows(unsigned char* ws, int grp, int T, int b, int h) { return kv_base(ws, grp) + (size_t)T * KV_TS + ((size_t)((b & 1) * 8 + h) * 2048) * 64 - (size_t)b * 2048 * 64; }
constexpr int LDS_SCR = 151552;
constexpr int LDSCTL_OFF = LDS_SCR, MISC_OFF = LDSCTL_OFF + 320;
constexpr int LDS_BYTES = 155648;
constexpr int NWAVES = 8, NTHREADS = 512;

#define RLX_AGENT __ATOMIC_RELAXED, __HIP_MEMORY_SCOPE_AGENT
#define LDS_WAIT() asm volatile("s_waitcnt lgkmcnt(0)" ::: "memory")
#define VM_WAIT() asm volatile("s_waitcnt vmcnt(0)" ::: "memory")
__device__ __forceinline__ unsigned pkh(float lo, float hi) { f32x2 v = {lo, hi}; h16x2 h = __builtin_convertvector(v, h16x2); return __builtin_bit_cast(unsigned, h); }
typedef __bf16 bf16x8 __attribute__((ext_vector_type(8)));
typedef __bf16 bf16x2 __attribute__((ext_vector_type(2)));
__device__ __forceinline__ unsigned pkb(float lo, float hi) { f32x2 v = {lo, hi}; bf16x2 h = __builtin_convertvector(v, bf16x2); return __builtin_bit_cast(unsigned, h); }
__device__ __forceinline__ unsigned pkb6(float lo, float hi) {
    unsigned a = __float_as_uint(lo), b = __float_as_uint(hi);
    a = (a + 0x1FFFFu + ((a >> 18) & 1u)) & 0xFFFC0000u; b = (b + 0x1FFFFu + ((b >> 18) & 1u)) & 0xFFFC0000u;
    return (a >> 16) | b;
}
__device__ __forceinline__ float bflo(unsigned w) { return __uint_as_float(w << 16); }
__device__ __forceinline__ float bfhi(unsigned w) { return __uint_as_float(w & 0xFFFF0000u); }
__device__ __forceinline__ float ex2(float x) { return __builtin_amdgcn_exp2f(x); }
__device__ __forceinline__ float xhalf(float v) { return __shfl_xor(v, 32); }
__device__ __forceinline__ float xhalf_max(float v) { auto rr = __builtin_amdgcn_permlane32_swap(__float_as_uint(v), __float_as_uint(v), false, false); const unsigned r0 = rr[0], r1 = rr[1]; return fmaxf(__uint_as_float(r0), __uint_as_float(r1)); }
__device__ __forceinline__ float xhalf_sum(float v) { auto rr = __builtin_amdgcn_permlane32_swap(__float_as_uint(v), __float_as_uint(v), false, false); const unsigned r0 = rr[0], r1 = rr[1]; return __uint_as_float(r0) + __uint_as_float(r1); }
__device__ __forceinline__ int crow_c(int r) { return (r & 3) + 8 * (r >> 2); }
__device__ __forceinline__ h16x8 pack8(float a0, float a1, float a2, float a3, float a4, float a5, float a6, float a7) {
    u32x4 w; w.x = pkh(a0, a1); w.y = pkh(a2, a3); w.z = pkh(a4, a5); w.w = pkh(a6, a7); return __builtin_bit_cast(h16x8, w);
}

namespace pg8 {
constexpr int BM = 256, BK = 64, HALF = 128, HTB = HALF * BK * 2, STAGE_BYTES = 8 * HTB, NXCD = 8, WGM = 8;
__host__ __device__ __forceinline__ int lds_byte(int r, int c) { const int st = (r >> 4) * 2 + (c >> 5), rr = r & 15, cc = c & 31, ob = rr * 64 + cc * 2; return st * 1024 + (ob ^ (((ob >> 9) & 1) << 5)); }
__host__ __device__ __forceinline__ void stage_rc(int b, int& R, int& C) { const int st = b / 1024, sb = b % 1024, swz = sb ^ (((sb >> 9) & 1) << 5); R = (st >> 1) * 16 + swz / 64; C = (st & 1) * 32 + (swz % 64) / 2; }
__host__ __device__ __forceinline__ int perm32(int rho) { const int n = rho >> 4, i = rho & 15; return 8 * (i >> 2) + 4 * n + (i & 3); }
struct Unit { int pm, pn; };
struct Gemm { const h16* A; const h16* Bt; int lda, ldb, K; };
struct StaticOrder {
    int nN, nwg, r, pm0;
    __device__ void init(int N, int grp, int r_) { nN = N / BM; nwg = 16 * nN; r = r_; pm0 = 16 * grp; }
    __device__ bool next(int i, Unit& u) const {
        const int L = i * 32 + r; if (L >= nwg) return false;
        const int nig = WGM * nN, gid = L / nig, rem = L % nig;
        u.pm = pm0 + gid * WGM + (rem % WGM); u.pn = rem / WGM; return true;
    }
};

struct EpiSwiGLU {
    static constexpr bool PERM = true, BF = true;
    h16* O; int ldc; const LAS float* rt; int rbase;
    __device__ __forceinline__ void operator()(const f32x4 (&acc)[2][2][4][2], const Unit& u, int wr, int wc, int fr, int fq) const {
        const int row0 = u.pm * BM + wr * 64 + fr, col0 = u.pn * HALF + wc * 32 + 8 * fq;
#pragma unroll
        for (int ai = 0; ai < 2; ++ai)
#pragma unroll
            for (int m = 0; m < 4; ++m) {
                const int row = row0 + ai * HALF + m * 16;
                const float rinv = rt[row - rbase]; const float q = __builtin_amdgcn_rcpf(rinv * rinv), rneg = -rinv;
                float o[8];
#pragma unroll
                for (int n = 0; n < 2; ++n) {
                    const f32x4 gv = acc[ai][0][m][n], uv = acc[ai][1][m][n];
                    const f32x4 xn = gv * rneg, gu = gv * uv;
                    f32x4 ev; ev[0] = ex2(xn[0]); ev[1] = ex2(xn[1]); ev[2] = ex2(xn[2]); ev[3] = ex2(xn[3]);
                    const f32x4 den = ev * q + q;
                    f32x4 rc; rc[0] = __builtin_amdgcn_rcpf(den[0]); rc[1] = __builtin_amdgcn_rcpf(den[1]); rc[2] = __builtin_amdgcn_rcpf(den[2]); rc[3] = __builtin_amdgcn_rcpf(den[3]);
                    const f32x4 ov = gu * rc;
                    o[4 * n + 0] = ov[0]; o[4 * n + 1] = ov[1]; o[4 * n + 2] = ov[2]; o[4 * n + 3] = ov[3];
                }
                u32x4 w; w.x = pkb(o[0], o[1]); w.y = pkb(o[2], o[3]); w.z = pkb(o[4], o[5]); w.w = pkb(o[6], o[7]);
                *(u32x4*)(O + (size_t)row * ldc + col0) = w;
            }
    }
};
struct EpiResid {
    static constexpr bool PERM = true, BF = true;
    h16* H; u64* ssout; float cmul;
    __device__ __forceinline__ void operator()(const f32x4 (&acc)[2][2][4][2], const Unit& u, int wr, int wc, int fr, int fq) const {
        const int row0 = u.pm * BM + wr * 64 + fr, col0 = u.pn * BM + wc * 32 + 8 * fq;
#pragma unroll
        for (int ai = 0; ai < 2; ++ai) {
            h16x8 hv[4][2];
#pragma unroll
            for (int m = 0; m < 4; ++m) { const h16* hp = H + (size_t)(row0 + ai * HALF + m * 16) * DM + col0; hv[m][0] = *(const h16x8*)hp; hv[m][1] = *(const h16x8*)(hp + HALF); }
#pragma unroll
            for (int m = 0; m < 4; ++m) {
                const int row = row0 + ai * HALF + m * 16; h16* hp = H + (size_t)row * DM + col0; float s = 0.f;
#pragma unroll
                for (int bj = 0; bj < 2; ++bj) {
                    const u32x4 hx = __builtin_bit_cast(u32x4, hv[m][bj]); float o[8];
#pragma unroll
                    for (int n = 0; n < 2; ++n)
#pragma unroll
                        for (int e = 0; e < 4; ++e) { const unsigned hw = hx[2 * n + (e >> 1)]; o[4 * n + e] = ((e & 1) ? bfhi(hw) : bflo(hw)) + acc[ai][bj][m][n][e] * cmul; }
                    u32x4 w; w.x = pkb(o[0], o[1]); w.y = pkb(o[2], o[3]); w.z = pkb(o[4], o[5]); w.w = pkb(o[6], o[7]);
                    *(u32x4*)(hp + bj * HALF) = w;
#pragma unroll
                    for (int e = 0; e < 4; ++e) { const float r0 = bflo(w[e]), r1 = bfhi(w[e]); s += r0 * r0; s += r1 * r1; }
                }
                s += __shfl_xor(s, 16); s += __shfl_xor(s, 32);
                if (fq == 0) (void)__hip_atomic_fetch_add(ssout + row, ss_fix(s), RLX_AGENT);
            }
            asm volatile("" ::: "memory");
        }
    }
};
struct EpiH16 {
    static constexpr bool PERM = true, BF = true;
    h16* O; int ldc; const LAS float* rt; int rbase; u64* sscq; int cq_pn;
    h16* kv;
    __device__ __forceinline__ void operator()(const f32x4 (&acc)[2][2][4][2], const Unit& u, int wr, int wc, int fr, int fq) const {
        const int row0 = u.pm * BM + wr * 64 + fr, col0 = u.pn * BM + wc * 32 + 8 * fq;
        const bool docq = (sscq != nullptr) && (u.pn == cq_pn);
        h16* dbase[2]; int dpitch[2]; bool iskv[2];
#pragma unroll
        for (int bj = 0; bj < 2; ++bj) {
            if (!kv) { dbase[bj] = O + col0 + bj * HALF; dpitch[bj] = ldc; iskv[bj] = false; }
            else {
                const int hc = 2 * u.pn + bj, cin = wc * 32 + 8 * fq;
                int T = -1, hb = 0, pjcol = 0;
                if (hc < 4) pjcol = PJ_QA + hc * HALF;
                else if (hc < 12) { T = (hc - 4) >> 2; hb = ((hc - 4) & 3) * 2; }
                else if (hc < 14) pjcol = PJ_CQ + (hc - 12) * HALF;
                else if (hc < 22) { T = 2 + ((hc - 14) >> 2); hb = ((hc - 14) & 3) * 2; }
                else pjcol = PJ_KI + (hc - 22) * HALF;
                if (T < 0) { dbase[bj] = O + pjcol + cin; dpitch[bj] = PJP; iskv[bj] = false; }
                else { dbase[bj] = kv + (size_t)T * KV_TS + (size_t)(hb + (wc >> 1)) * 2048 * 64 + (wc & 1) * 32 + 8 * fq; dpitch[bj] = 64; iskv[bj] = true; }
            }
        }
#pragma unroll
        for (int ai = 0; ai < 2; ++ai)
#pragma unroll
            for (int m = 0; m < 4; ++m) {
                const int row = row0 + ai * HALF + m * 16;
                const float rinv = rt ? rt[row - rbase] : 1.0f;
                float s = 0.f;
#pragma unroll
                for (int bj = 0; bj < 2; ++bj) {
                    const f32x4 v0 = acc[ai][bj][m][0] * rinv, v1 = acc[ai][bj][m][1] * rinv;
                    u32x4 w; w.x = pkh(v0[0], v0[1]); w.y = pkh(v0[2], v0[3]); w.z = pkh(v1[0], v1[1]); w.w = pkh(v1[2], v1[3]);
                    const size_t off = iskv[bj] ? ((size_t)((row >> 11) & 1) * (8 * 2048 * 64) + (size_t)(row & 2047) * 64) : (size_t)row * dpitch[bj];
                    *(u32x4*)(dbase[bj] + off) = w;
                    s += (v0[0] * v0[0] + v0[1] * v0[1]) + (v0[2] * v0[2] + v0[3] * v0[3]) + (v1[0] * v1[0] + v1[1] * v1[1]) + (v1[2] * v1[2] + v1[3] * v1[3]);
                }
                if (docq) { s += __shfl_xor(s, 16); s += __shfl_xor(s, 32); if (fq == 0) (void)__hip_atomic_fetch_add(sscq + row, ss_fix(s), RLX_AGENT); }
            }
    }
};
struct EpiPlainH16 {
    static constexpr bool PERM = true, BF = false;
    h16* O; int ldc;
    __device__ __forceinline__ void operator()(const f32x4 (&acc)[2][2][4][2], const Unit& u, int wr, int wc, int fr, int fq) const {
        const int row0 = u.pm * BM + wr * 64 + fr, col0 = u.pn * BM + wc * 32 + 8 * fq;
#pragma unroll
        for (int ai = 0; ai < 2; ++ai)
#pragma unroll
            for (int m = 0; m < 4; ++m) {
                h16* op = O + (size_t)(row0 + ai * HALF + m * 16) * ldc + col0;
#pragma unroll
                for (int bj = 0; bj < 2; ++bj) {
                    const f32x4 v0 = acc[ai][bj][m][0], v1 = acc[ai][bj][m][1];
                    u32x4 w; w.x = pkh(v0[0], v0[1]); w.y = pkh(v0[2], v0[3]); w.z = pkh(v1[0], v1[1]); w.w = pkh(v1[2], v1[3]);
                    *(u32x4*)(op + bj * HALF) = w;
                }
            }
    }
};
template <bool BF> __device__ __forceinline__ f32x4 mma16(const h16x8& a, const h16x8& b, const f32x4& c) {
    if constexpr (BF) return __builtin_amdgcn_mfma_f32_16x16x32_bf16(__builtin_bit_cast(bf16x8, a), __builtin_bit_cast(bf16x8, b), c, 0, 0, 0);
    else return __builtin_amdgcn_mfma_f32_16x16x32_f16(a, b, c, 0, 0, 0);
}
constexpr int RT_OFF = STAGE_BYTES;
__device__ __forceinline__ const LAS float* stage_rinv(LAS unsigned char* lds, const u64* ss, int rbase, int tid) {
    LAS float* rt = (LAS float*)(lds + RT_OFF);
#pragma unroll
    for (int i = 0; i < 8; ++i) rt[tid + 512 * i] = __builtin_amdgcn_rsqf(ss_val(ss[rbase + tid + 512 * i]) * (1.0f / DM) + EPS);
    __syncthreads();
    return rt;
}
struct RinvSrc { const u64* ss; int rbase; };
__device__ __forceinline__ void stage_rinv_nosync(LAS unsigned char* lds, const RinvSrc& r, int tid) {
    if (!r.ss) return;
    LAS float* rt = (LAS float*)(lds + RT_OFF);
#pragma unroll
    for (int i = 0; i < 8; ++i) rt[tid + 512 * i] = __builtin_amdgcn_rsqf(ss_val(r.ss[r.rbase + tid + 512 * i]) * (1.0f / DM) + EPS);
}
template <class Epi, bool ALIGN_EPI>
__device__ __forceinline__ void gemm_phase(LAS unsigned char* lds, const int tid, const Gemm g, const StaticOrder& S, const Epi& E, const RinvSrc rs = RinvSrc{nullptr, 0}) {
    const int wid = __builtin_amdgcn_readfirstlane(tid >> 6), lane = tid & 63, wr = wid >> 2, wc = wid & 3, fr = lane & 15, fq = lane >> 4;
    const int K = g.K, nt = K / BK;
    unsigned voffA[2], voffB[2];
#pragma unroll
    for (int i = 0; i < 2; ++i) { int R, C; stage_rc(tid * 16 + i * 8192, R, C); const int Rb = Epi::PERM ? ((R & ~31) + perm32(R & 31)) : R;
        voffA[i] = (unsigned)(R * g.lda + C) * 2u; voffB[i] = (unsigned)(Rb * g.ldb + C) * 2u; }
    const size_t kstep = (size_t)(BK * 2);
    const size_t hstepA = (size_t)HALF * g.lda * 2, hstepB = (size_t)HALF * g.ldb * 2;
    const size_t tstepA = 2 * hstepA, tstepB = 2 * hstepB;
    const unsigned ldsw = (unsigned)wid * 1024u;
    const int aoff = lds_byte(wr * 64 + fr, fq * 8), boff = lds_byte(wc * 32 + fr, fq * 8);
#define PG8_SA(b, h) (((b) * 2 + (h)) * HTB)
#define PG8_SB(b, h) ((4 + (b) * 2 + (h)) * HTB)
#define PG8_STAGE(bufoff, gbase, voff) do { _Pragma("unroll") for (int _i = 0; _i < 2; ++_i) \
        __builtin_amdgcn_global_load_lds((const unsigned*)((const char*)(gbase) + (voff)[_i]), (LAS unsigned*)(lds + (bufoff) + ldsw + _i * 8192), 16, 0, 0); } while (0)
#define PG8_LDA(dst, b, h) do { _Pragma("unroll") for (int m = 0; m < 4; ++m) _Pragma("unroll") for (int k = 0; k < 2; ++k) dst[m][k] = *(const LAS h16x8*)(lds + PG8_SA(b, h) + aoff + m * 2048 + k * 1024); } while (0)
#define PG8_LDB(dst, b, h) do { _Pragma("unroll") for (int n = 0; n < 2; ++n) _Pragma("unroll") for (int k = 0; k < 2; ++k) dst[n][k] = *(const LAS h16x8*)(lds + PG8_SB(b, h) + boff + n * 2048 + k * 1024); } while (0)
#define PG8_MMA(ai, bj, At, Bt) do { __builtin_amdgcn_s_setprio(1); _Pragma("unroll") for (int m = 0; m < 4; ++m) _Pragma("unroll") for (int n = 0; n < 2; ++n) _Pragma("unroll") for (int k = 0; k < 2; ++k) \
        acc[ai][bj][m][n] = mma16<Epi::BF>(Bt[n][k], At[m][k], acc[ai][bj][m][n]); __builtin_amdgcn_s_setprio(0); } while (0)
#define PG8_WAIT_V(n) asm volatile("s_waitcnt vmcnt(" #n ")" ::: "memory")
#define PG8_WAIT_L(n) asm volatile("s_waitcnt lgkmcnt(" #n ")" ::: "memory")
#define PG8_BAR __builtin_amdgcn_s_barrier()
#define PG8_SCHED __builtin_amdgcn_sched_barrier(0)
    Unit cur, nxt; int ui = 0;
    if (!S.next(0, cur)) return;
    f32x4 acc[2][2][4][2];
#pragma unroll
    for (int a = 0; a < 2; ++a)
#pragma unroll
        for (int b = 0; b < 2; ++b)
#pragma unroll
            for (int m = 0; m < 4; ++m)
#pragma unroll
                for (int n = 0; n < 2; ++n) acc[a][b][m][n] = (f32x4){0.f, 0.f, 0.f, 0.f};
    h16x8 At[4][2], B0[2][2], B1[2][2];
    const char* cA = (const char*)g.A + (size_t)cur.pm * tstepA; const char* cB = (const char*)g.Bt + (size_t)cur.pn * tstepB;
    PG8_STAGE(PG8_SB(0, 0), cB, voffB); PG8_STAGE(PG8_SB(0, 1), cB + hstepB, voffB); PG8_STAGE(PG8_SA(0, 0), cA, voffA); PG8_STAGE(PG8_SA(0, 1), cA + hstepA, voffA);
    stage_rinv_nosync(lds, rs, tid);
    if (wr == 1) PG8_BAR;
    PG8_WAIT_V(2); PG8_BAR;
    PG8_STAGE(PG8_SB(1, 0), cB + kstep, voffB); PG8_STAGE(PG8_SA(1, 0), cA + kstep, voffA); PG8_STAGE(PG8_SB(1, 1), cB + hstepB + kstep, voffB);
    PG8_WAIT_V(6); PG8_BAR;
    for (;;) {
        const bool has_next = S.next(ui + 1, nxt);
        const char* nA = has_next ? (const char*)g.A + (size_t)nxt.pm * tstepA : cA; const char* nB = has_next ? (const char*)g.Bt + (size_t)nxt.pn * tstepB : cB;
        for (int t = 0; t < nt; t += 2) {
            const bool last = (t == nt - 2);
            const char* a1 = cA + (size_t)(t + 1) * kstep;
            const char* a2 = last ? nA : cA + (size_t)(t + 2) * kstep; const char* b2 = last ? nB : cB + (size_t)(t + 2) * kstep;
            const char* a3 = a2 + kstep; const char* b3 = b2 + kstep;
            PG8_LDB(B0, 0, 0); PG8_LDB(B1, 0, 1); PG8_SCHED; PG8_LDA(At, 0, 0); PG8_STAGE(PG8_SA(1, 1), a1 + hstepA, voffA);
            PG8_WAIT_V(8); PG8_WAIT_L(0); PG8_BAR; PG8_MMA(0, 0, At, B0); PG8_MMA(0, 1, At, B1); PG8_BAR; PG8_SCHED;
            PG8_LDA(At, 0, 1); PG8_STAGE(PG8_SB(0, 0), b2, voffB); PG8_STAGE(PG8_SB(0, 1), b2 + hstepB, voffB); PG8_STAGE(PG8_SA(0, 0), a2, voffA);
            PG8_WAIT_V(8); PG8_WAIT_L(0); PG8_BAR; PG8_MMA(1, 0, At, B0); PG8_MMA(1, 1, At, B1); PG8_BAR; PG8_SCHED;
            PG8_LDB(B0, 1, 0); PG8_LDB(B1, 1, 1); PG8_SCHED; PG8_LDA(At, 1, 0); PG8_STAGE(PG8_SA(0, 1), a2 + hstepA, voffA);
            PG8_WAIT_V(8); PG8_WAIT_L(0); PG8_BAR; PG8_MMA(0, 0, At, B0); PG8_MMA(0, 1, At, B1); PG8_BAR; PG8_SCHED;
            PG8_LDA(At, 1, 1); PG8_STAGE(PG8_SB(1, 0), b3, voffB); PG8_STAGE(PG8_SB(1, 1), b3 + hstepB, voffB); PG8_STAGE(PG8_SA(1, 0), a3, voffA);
            PG8_WAIT_V(8); PG8_WAIT_L(0); PG8_BAR; PG8_MMA(1, 0, At, B0); PG8_MMA(1, 1, At, B1); PG8_BAR; PG8_SCHED;
        }
        if constexpr (ALIGN_EPI) { if (wr == 0) PG8_BAR; }
        E(acc, cur, wr, wc, fr, fq);
        if (!has_next) break;
#pragma unroll
        for (int a = 0; a < 2; ++a)
#pragma unroll
            for (int b = 0; b < 2; ++b)
#pragma unroll
                for (int m = 0; m < 4; ++m)
#pragma unroll
                    for (int n = 0; n < 2; ++n) acc[a][b][m][n] = (f32x4){0.f, 0.f, 0.f, 0.f};
        cur = nxt; cA = nA; cB = nB; ++ui;
        if constexpr (ALIGN_EPI) { if (wr == 1) PG8_BAR; }
    }
    PG8_WAIT_V(0);
    if constexpr (!ALIGN_EPI) { if (wr == 0) PG8_BAR; }
    PG8_BAR;
#undef PG8_SA
#undef PG8_SB
#undef PG8_STAGE
#undef PG8_LDA
#undef PG8_LDB
#undef PG8_MMA
#undef PG8_WAIT_V
#undef PG8_WAIT_L
#undef PG8_BAR
#undef PG8_SCHED
}
}

#define XB_TMO      128
#define XB_XCNT(j)  (256  + 64 * (j))
#define XB_XSUB(j)  (1280 + 64 * (j))
#define XB_XGEN(j)  (2304 + 64 * (j))
#define XB_TOP      3328
#define XB_TOPGEN   3392
#define XCD_BAR_WORDS 3456
#define XB_SPIN_CAP (1u << 18)
__device__ __forceinline__ unsigned xb_ld(unsigned* p)              { return __hip_atomic_load(p, __ATOMIC_RELAXED, __HIP_MEMORY_SCOPE_AGENT); }
__device__ __forceinline__ unsigned xb_add(unsigned* p, unsigned v) { return __hip_atomic_fetch_add(p, v, __ATOMIC_RELAXED, __HIP_MEMORY_SCOPE_AGENT); }
__device__ __forceinline__ unsigned xb_xcc_id() { return (unsigned)__builtin_amdgcn_s_getreg((3 << 11) | 20) & 0xFu; }
#define XB_SPIN(cond, bar) do { unsigned _sp = 0; while (cond) { __builtin_amdgcn_s_sleep(1); \
    if ((++_sp & 255u) == 0u) { if (xb_ld(&(bar)[XB_TMO])) break; if (_sp > XB_SPIN_CAP) { atomicAdd(&(bar)[XB_TMO], 1u); break; } } } } while (0)
__device__ __forceinline__ void xcd_barrier_post(unsigned* bar) { if (threadIdx.x == 0) (void)xb_add(&bar[XB_XCNT(xb_xcc_id())], 1u); }
__device__ __forceinline__ void xcd_barrier_complete(unsigned* bar, unsigned x, unsigned G, unsigned& nloc, unsigned& nx) {
    unsigned sum, cnt, mine, sp = 0u;
    for (;;) {
        sum = 0u; cnt = 0u; mine = 0u;
#pragma unroll
        for (unsigned j = 0; j < 16; ++j) { const unsigned c = xb_ld(&bar[XB_XCNT(j)]); sum += c; cnt += (c > 0u) ? 1u : 0u; mine = (j == x) ? c : mine; }
        if (sum == G) break;
        __builtin_amdgcn_s_sleep(1);
        if ((++sp & 255u) == 0u) { if (xb_ld(&bar[XB_TMO])) break; if (sp > XB_SPIN_CAP) { atomicAdd(&bar[XB_TMO], 1u); break; } }
    }
    nloc = mine > 0u ? mine : 1u; nx = cnt > 0u ? cnt : 1u;
}
template <bool FAST>
__device__ __forceinline__ void xcd_barrier(unsigned* bar, volatile LAS unsigned* st, unsigned Gtot) {
    asm volatile("s_waitcnt vmcnt(0)" ::: "memory");
    __syncthreads();
    if (threadIdx.x == 0) {
        __builtin_amdgcn_s_waitcnt(0);
        const unsigned x = xb_xcc_id();
        unsigned nloc = st[0], nx = st[1];
        if (nloc == 0u) { xcd_barrier_complete(bar, x, Gtot, nloc, nx); st[0] = nloc; st[1] = nx; }
        const unsigned old = xb_add(&bar[XB_XSUB(x)], 1u);
        const unsigned gen = old / nloc;
        if (FAST && nx == 1u) {
            const unsigned target = (gen + 1u) * nloc;
            if (old + 1u != target) XB_SPIN(xb_ld(&bar[XB_XSUB(x)]) < target, bar);
            __builtin_amdgcn_fence(__ATOMIC_ACQUIRE, "agent");
            asm volatile("s_waitcnt vmcnt(0)" ::: "memory");
        } else if (old + 1u == (gen + 1u) * nloc) {
            if (!(FAST && nx == 1u)) {
                __builtin_amdgcn_fence(__ATOMIC_RELEASE, "agent");
                asm volatile("s_waitcnt vmcnt(0)" ::: "memory");
                const unsigned og = xb_add(&bar[XB_TOP], 1u);
                const unsigned tg = og / nx;
                if (og + 1u == (tg + 1u) * nx) xb_add(&bar[XB_TOPGEN], 1u);
                else XB_SPIN(xb_ld(&bar[XB_TOPGEN]) == tg, bar);
            }
            __builtin_amdgcn_fence(__ATOMIC_ACQUIRE, "agent");
            xb_add(&bar[XB_XGEN(x)], 1u);
            asm volatile("s_waitcnt vmcnt(0)" ::: "memory");
        } else {
            XB_SPIN(xb_ld(&bar[XB_XGEN(x)]) == gen, bar);
            __builtin_amdgcn_fence(__ATOMIC_ACQUIRE, "agent");
            asm volatile("s_waitcnt vmcnt(0)" ::: "memory");
        }
    }
    __syncthreads();
}

struct Args {
    const float* x; const float* norm_g; const float* final_g; const float* table; const float* w1; const float* w3; const float* w2;
    const float* hyb_w_in; const float* hyb_cq_g; const float* hyb_wq_b; const float* hyb_wq_idx; const float* hyb_w_out;
    const float* swa_w_in; const float* swa_sinks; const float* swa_w_out;
    float* out; unsigned char* ws; int ph_lo, ph_hi;
};

struct TrItem { const float* src; const float* gain; h16* dst; int ldsrc, col0, nvalid, K, k0; float cs; int bf; };
__device__ __forceinline__ void tr_load(const TrItem& I, int lane, float (&tv)[32], float (&tg)[32]) {
    const int c = I.col0 + (lane & 31); const bool ok = c < I.nvalid;
#pragma unroll
    for (int i = 0; i < 32; ++i) { const int kk = 2 * i + (lane >> 5); tv[i] = ok ? I.src[(size_t)(I.k0 + kk) * I.ldsrc + c] : 0.f; tg[i] = (I.gain ? I.gain[I.k0 + kk] : 1.0f) * I.cs; }
}
__device__ __forceinline__ void tr_store(const TrItem& I, int lane, const float (&tv)[32], const float (&tg)[32], LAS float* scr) {
#pragma unroll
    for (int i = 0; i < 32; ++i) { const int kk = 2 * i + (lane >> 5); scr[kk * 33 + (lane & 31)] = tv[i] * tg[i]; }
    LDS_WAIT(); asm volatile("" ::: "memory");
    const int ch = lane & 7;
#pragma unroll
    for (int j = 0; j < 4; ++j) { const int n = (lane >> 3) + 8 * j; const LAS float* sp = scr + (8 * ch) * 33 + n;
        u32x4 o;
        if (I.bf) { o.x = pkb6(sp[0 * 33], sp[1 * 33]); o.y = pkb6(sp[2 * 33], sp[3 * 33]); o.z = pkb6(sp[4 * 33], sp[5 * 33]); o.w = pkb6(sp[6 * 33], sp[7 * 33]); }
        else { o.x = pkh(sp[0 * 33], sp[1 * 33]); o.y = pkh(sp[2 * 33], sp[3 * 33]); o.z = pkh(sp[4 * 33], sp[5 * 33]); o.w = pkh(sp[6 * 33], sp[7 * 33]); }
        *(u32x4*)(I.dst + (size_t)n * I.K + I.k0 + 8 * ch) = o; }
    LDS_WAIT(); asm volatile("" ::: "memory");
}
__device__ __forceinline__ int t5_bucket(int d) {
    if (d < 16) return d;
    int b = 16;
    b += (d >= 22) + (d >= 30) + (d >= 40) + (d >= 54) + (d >= 73) + (d >= 99) + (d >= 134) + (d >= 182) + (d >= 246) + (d >= 332) + (d >= 450) + (d >= 609) + (d >= 825) + (d >= 1117) + (d >= 1513);
    return b;
}
constexpr int PI13 = (DM / 64) * (2 * FF / 32), PI2 = (FF / 64) * (DM / 32), PIWE = (DM / 64) * (EINP / 32), PIWQ = (256 / 64) * (QBW / 32), PIWO = (DM / 64) * (DM / 32), PIWI = (DM / 64) * (OIN / 32);
constexpr int P_NITEMS = 4 * PI13 + 4 * PI2 + PIWE + PIWQ + PIWO + PIWI + PIWO;
__device__ __forceinline__ TrItem decode_item(const Args& a, h16* wb, int it) {
    TrItem I; I.cs = 1.0f; I.bf = 0; int r = it;
    if (r < 4 * PI13) { const int lj = r / PI13; r -= lj * PI13; const int l = lj >> 1, j = lj & 1; const int kb = r / 176, nb = r % 176, t = nb >> 3, wbk = nb & 7;
        I.src = (wbk < 4 ? a.w1 : a.w3) + (size_t)lj * DM * FF; I.ldsrc = FF; I.col0 = 128 * t + 32 * (wbk & 3); I.nvalid = FF; I.gain = a.norm_g + (l * 3 + 2 * j) * DM; I.K = DM; I.k0 = 64 * kb; I.cs = wbk < 4 ? LOG2E : 1.0f / LOG2E; I.bf = 1;

        I.dst = wb + (WO_W13 + lj * W13_BYTES) / 2 + (size_t)(32 * nb) * DM; return I; }
    r -= 4 * PI13;
    if (r < 4 * PI2) { const int lj = r / PI2; r -= lj * PI2; const int kb = r / 32, nb = r % 32;
        I.src = a.w2 + (size_t)lj * FF * DM; I.ldsrc = DM; I.col0 = 32 * nb; I.nvalid = DM; I.gain = nullptr; I.bf = 1; I.K = FF; I.k0 = 64 * kb; I.dst = wb + (WO_W2 + lj * W2_BYTES) / 2 + (size_t)(32 * nb) * FF; return I; }
    r -= 4 * PI2;
    if (r < PIWE) { const int kb = r / 96, nb = r % 96;
        I.src = a.hyb_w_in; I.ldsrc = EIN; I.col0 = 32 * nb; I.nvalid = EIN; I.gain = a.norm_g + 1 * DM; I.bf = 1; if (nb < 16) I.cs = QSCALE2;   I.K = DM; I.k0 = 64 * kb; I.dst = wb + WO_WINE / 2 + (size_t)(32 * nb) * DM; return I; }
    r -= PIWE;
    if (r < PIWQ) { const int kb = r / 24, nb = r % 24; I.gain = a.hyb_cq_g; I.K = 256; I.k0 = 64 * kb; I.dst = wb + WO_WQ / 2 + (size_t)(32 * nb) * 256;
        if (nb < 16) { I.src = a.hyb_wq_b; I.ldsrc = 512; I.col0 = 32 * nb; I.nvalid = 512; } else { I.src = a.hyb_wq_idx; I.ldsrc = 256; I.col0 = 32 * (nb - 16); I.nvalid = 256; }
        return I; }
    r -= PIWQ;
    if (r < PIWO) { const int kb = r / 32, nb = r % 32;
        I.src = a.hyb_w_out; I.ldsrc = DM; I.col0 = 32 * nb; I.nvalid = DM; I.gain = nullptr; I.bf = 1; I.K = DM; I.k0 = 64 * kb; I.dst = wb + WO_WOUTE / 2 + (size_t)(32 * nb) * DM; return I; }
    r -= PIWO;
    if (r < PIWI) { const int kb = r / 40, nb = r % 40;
        I.src = a.swa_w_in; I.ldsrc = OIN; I.col0 = 32 * nb; I.nvalid = OIN; I.gain = a.norm_g + (3 + 1) * DM; I.bf = 1; if (nb < 32) I.cs = QSCALE2;   I.K = DM; I.k0 = 64 * kb; I.dst = wb + WO_WINO / 2 + (size_t)(32 * nb) * DM; return I; }
    r -= PIWI;
    { const int kb = r / 32, nb = r % 32;
        I.src = a.swa_w_out; I.ldsrc = DM; I.col0 = 32 * nb; I.nvalid = DM; I.gain = nullptr; I.bf = 1; I.K = DM; I.k0 = 64 * kb; I.dst = wb + WO_WOUTO / 2 + (size_t)(32 * nb) * DM; return I; }
}
__device__ __forceinline__ void prologue(const Args& a, unsigned char* ws, LAS unsigned char* lds, int gw, int NGW, int wave, int lane) {
    LAS float* scr = (LAS float*)(lds + wave * 16384);
    h16* wb = (h16*)(ws + WS_W);
    if (gw < P_NITEMS) {
        TrItem cur = decode_item(a, wb, gw); float tv[32], tg[32];
        tr_load(cur, lane, tv, tg);
        for (int it = gw; it < P_NITEMS; it += NGW) {
            const bool more = it + NGW < P_NITEMS; TrItem nxt = cur; float nv[32], ng[32];
            if (more) { nxt = decode_item(a, wb, it + NGW); tr_load(nxt, lane, nv, ng); }
            tr_store(cur, lane, tv, tg, scr);
            if (more) { cur = nxt;
#pragma unroll
                for (int i = 0; i < 32; ++i) { tv[i] = nv[i]; tg[i] = ng[i]; } }
        }
    }
    { float* lut = (float*)(ws + WS_LUT);
      for (int i = gw * 64 + lane; i < 16 * LUTP; i += NGW * 64) { const int h = i / LUTP, d = i % LUTP; lut[i] = a.table[t5_bucket(d < 2048 ? d : 2047) * 16 + h] * LOG2E; } }
    { h16* XN = (h16*)(ws + WS_XN); u64* ss0 = (u64*)(ws + WS_SS);
      for (int m0 = gw; m0 < M; m0 += 4 * NGW) {
          f32x4 v[4][4];
#pragma unroll
          for (int r = 0; r < 4; ++r) { const int m = m0 + r * NGW; if (m < M) { const f32x4* xr = (const f32x4*)(a.x + (size_t)m * DM) + lane;
#pragma unroll
              for (int j = 0; j < 4; ++j) v[r][j] = xr[64 * j]; } }
#pragma unroll
          for (int r = 0; r < 4; ++r) { const int m = m0 + r * NGW; if (m < M) { float s = 0.f; u32x2* o8 = (u32x2*)(XN + (size_t)m * DM) + lane;
#pragma unroll
              for (int j = 0; j < 4; ++j) { const f32x4 x = v[r][j]; s += (x[0] * x[0] + x[1] * x[1]) + (x[2] * x[2] + x[3] * x[3]); u32x2 w; w.x = pkb(x[0], x[1]); w.y = pkb(x[2], x[3]); o8[64 * j] = w; }
#pragma unroll
              for (int o = 1; o < 64; o <<= 1) s += __shfl_xor(s, o);
              if (lane == 0) ss0[m] = ss_fix(s); } }
      } }
}

__device__ __forceinline__ h16x4 vtr(const LAS unsigned char* p) { return __builtin_bit_cast(h16x4, __builtin_amdgcn_ds_read_tr16_b64_v4i16((LAS v4i16_t*)p)); }
template <int NK> struct KVImg { static constexpr int KCH = NK * 16 + 16, KBYTES = 8 * KCH, VDH = NK * 64 + 64, VBYTES = 2 * VDH; };
template <int NK> __device__ __forceinline__ f32x16 qk_tile(const LAS unsigned char* Kimg, int kr0, const h16x8 (&qf)[4], int r32, int hi, f32x16 acc = f32x16{}) {
    const LAS unsigned char* kp = Kimg + hi * KVImg<NK>::KCH + (kr0 + r32) * 16;
#pragma unroll
    for (int ks = 0; ks < 4; ++ks) { const h16x8 kf = *(const LAS h16x8*)(kp + 2 * ks * KVImg<NK>::KCH); acc = __builtin_amdgcn_mfma_f32_32x32x16_f16(kf, qf[ks], acc, 0, 0, 0); }
    return acc;
}
template <int NK> __device__ __forceinline__ void pv_tile(f32x16 (&o)[2], const LAS unsigned char* Vimg, int kr0, const f32x16& p, int lane, int hi) {
    const LAS unsigned char* vp = Vimg + (kr0 + 4 * hi + ((lane & 15) >> 2)) * 64 + ((lane >> 4) & 1) * 32 + (lane & 3) * 8;
#pragma unroll
    for (int s = 0; s < 2; ++s) {
        const h16x8 pf = pack8(p[8 * s + 0], p[8 * s + 1], p[8 * s + 2], p[8 * s + 3], p[8 * s + 4], p[8 * s + 5], p[8 * s + 6], p[8 * s + 7]);
#pragma unroll
        for (int d0 = 0; d0 < 2; ++d0) {
            const h16x4 lo = vtr(vp + d0 * KVImg<NK>::VDH + s * 1024), hv = vtr(vp + d0 * KVImg<NK>::VDH + s * 1024 + 512);
            const h16x8 vf = {lo[0], lo[1], lo[2], lo[3], hv[0], hv[1], hv[2], hv[3]};
            o[d0] = __builtin_amdgcn_mfma_f32_32x32x16_f16(vf, pf, o[d0], 0, 0, 0);
        }
    }
}
template <int NK> __device__ __forceinline__ void pv_tile_pk(f32x16 (&o)[2], const LAS unsigned char* Vimg, int kr0, const unsigned (&pp)[8], int lane, int hi) {
    const LAS unsigned char* vp = Vimg + (kr0 + 4 * hi + ((lane & 15) >> 2)) * 64 + ((lane >> 4) & 1) * 32 + (lane & 3) * 8;
#pragma unroll
    for (int s = 0; s < 2; ++s) {
        const u32x4 pw = {pp[4 * s + 0], pp[4 * s + 1], pp[4 * s + 2], pp[4 * s + 3]};
        const h16x8 pf = __builtin_bit_cast(h16x8, pw);
#pragma unroll
        for (int d0 = 0; d0 < 2; ++d0) {
            const h16x4 lo = vtr(vp + d0 * KVImg<NK>::VDH + s * 1024), hv = vtr(vp + d0 * KVImg<NK>::VDH + s * 1024 + 512);
            const h16x8 vf = {lo[0], lo[1], lo[2], lo[3], hv[0], hv[1], hv[2], hv[3]};
            o[d0] = __builtin_amdgcn_mfma_f32_32x32x16_f16(vf, pf, o[d0], 0, 0, 0);
        }
    }
}
template <int NK> __device__ __forceinline__ void fill_kv(LAS unsigned char* Kimg, LAS unsigned char* Vimg, const h16* base, long grow0, int gstride, int ld, int kcol, int vcol, int r_lo, int r_hi, int tid, int nthr) {
    const int npieces = (r_hi - r_lo) * 8;
    for (int p = tid; p < npieces; p += nthr) {
        const int row = r_lo + (p >> 3), c = p & 7;
        const h16* g = base + (size_t)(grow0 + (long)row * gstride) * ld + c * 8;
        const u32x4 kv = *(const u32x4*)(g + kcol), vv = *(const u32x4*)(g + vcol);
        *(LAS u32x4*)(Kimg + c * KVImg<NK>::KCH + row * 16) = kv;
        *(LAS u32x4*)(Vimg + (c >> 2) * KVImg<NK>::VDH + row * 64 + (c & 3) * 16) = vv;
    }
}

struct BandTask {
    h16* orow;
    float* lsep;
    int mode; float sink2;
    int qsub; bool has_prev;
    int flip;
};
struct BandPre { h16x8 qf[4]; float lv[3]; };
__device__ __forceinline__ void band_prefetch(BandPre& B, const h16* qrow, const float* lutg, int dil, int maxd, int lane) {
    const int hi = lane >> 5;
#pragma unroll
    for (int ks = 0; ks < 4; ++ks) B.qf[ks] = *(const h16x8*)(qrow + ks * 16 + hi * 8);
#pragma unroll
    for (int j = 0; j < 3; ++j) { const int rel = lane + 64 * j - 31; const bool ok = rel >= 0 && rel <= maxd;
        const float v = lutg[(ok ? rel : 0) * dil]; B.lv[j] = ok ? v : -INFINITY; }
}
__device__ __forceinline__ void band_task(const BandTask& T, const BandPre& B, const LAS unsigned char* Kimg, const LAS unsigned char* Vimg, LAS float* lut, int lane) {
    const int r32 = lane & 31, hi = lane >> 5;
#pragma unroll
    for (int j = 0; j < 3; ++j) lut[lane + 64 * j] = B.lv[j];
    u32x2 oold[2][4]; float lold = 0.f;
    LDS_WAIT(); asm volatile("" ::: "memory");
    const int laneb = r32 - 4 * hi + 4;
    float mref = 0.f, l = 0.f; f32x16 o[2]; o[0] = f32x16{}; o[1] = f32x16{};
#pragma unroll
    for (int ii = 0; ii < 5; ++ii) {
        const int i = 4 - ii; const int kr0 = 32 * T.qsub + 32 * i;
        if (ii == 3 && (T.mode == 1 || T.mode == 2)) {
            lold = *T.lsep;
#pragma unroll
            for (int d0 = 0; d0 < 2; ++d0)
#pragma unroll
                for (int g4 = 0; g4 < 4; ++g4) oold[d0][g4] = *(const u32x2*)(T.orow + 32 * d0 + 8 * g4 + 4 * hi);
        }
        if (T.has_prev || kr0 >= 128) {
            f32x16 cin;
            { f32x2 p0, p1, p2, p3, p4, p5, p6, p7; const LAS float* la = lut + laneb + (128 - 32 * i);
              asm volatile("ds_read2_b32 %0, %1 offset0:27 offset1:26" : "=v"(p0) : "v"(la)); asm volatile("ds_read2_b32 %0, %1 offset0:25 offset1:24" : "=v"(p1) : "v"(la));
              asm volatile("ds_read2_b32 %0, %1 offset0:19 offset1:18" : "=v"(p2) : "v"(la)); asm volatile("ds_read2_b32 %0, %1 offset0:17 offset1:16" : "=v"(p3) : "v"(la));
              asm volatile("ds_read2_b32 %0, %1 offset0:11 offset1:10" : "=v"(p4) : "v"(la)); asm volatile("ds_read2_b32 %0, %1 offset0:9 offset1:8" : "=v"(p5) : "v"(la));
              asm volatile("ds_read2_b32 %0, %1 offset0:3 offset1:2" : "=v"(p6) : "v"(la)); asm volatile("ds_read2_b32 %0, %1 offset0:1 offset1:0" : "=v"(p7) : "v"(la));
              asm volatile("s_waitcnt lgkmcnt(0)" : "+v"(p0), "+v"(p1), "+v"(p2), "+v"(p3), "+v"(p4), "+v"(p5), "+v"(p6), "+v"(p7) :: "memory");
              cin[0] = p0[0] - mref; cin[1] = p0[1] - mref; cin[2] = p1[0] - mref; cin[3] = p1[1] - mref; cin[4] = p2[0] - mref; cin[5] = p2[1] - mref; cin[6] = p3[0] - mref; cin[7] = p3[1] - mref;
              cin[8] = p4[0] - mref; cin[9] = p4[1] - mref; cin[10] = p5[0] - mref; cin[11] = p5[1] - mref; cin[12] = p6[0] - mref; cin[13] = p6[1] - mref; cin[14] = p7[0] - mref; cin[15] = p7[1] - mref; }
            f32x16 s = qk_tile<256>(Kimg, kr0 ^ T.flip, B.qf, r32, hi, cin); float mx = -INFINITY;
#pragma unroll
            for (int r = 0; r < 16; ++r) mx = fmaxf(mx, s[r]);
            mx = xhalf_max(mx);
            if (ii == 0 || __any(mx > 8.0f)) {
                const float dl = (ii == 0) ? mx : fmaxf(mx, 0.f);
                mref += dl; const float alpha = ex2(-dl); l *= alpha;
#pragma unroll
                for (int r = 0; r < 16; ++r) { s[r] -= dl; o[0][r] *= alpha; o[1][r] *= alpha; }
            }
#pragma unroll
            for (int r = 0; r < 16; ++r) { const float p = ex2(s[r]); s[r] = p; l += p; }
            pv_tile<256>(o, Vimg, kr0 ^ T.flip, s, lane, hi);
        }
    }
    l = xhalf_sum(l);
    const float mx = mref;
    const float inv = 1.0f / l;
    float lse = mx + __builtin_amdgcn_logf(l);
    float wc = inv, wo = 0.f;
    if (T.mode == 1 || T.mode == 2) {
        const float m2 = fmaxf(lold, lse); const float eo = ex2(lold - m2), ec = ex2(lse - m2); const float den = eo + ec;
        wo = eo / den; wc = inv * ec / den; lse = m2 + __builtin_amdgcn_logf(den);
    } else if (T.mode == 3) {
        wc = inv / (1.0f + ex2(T.sink2 - lse));
    }
#pragma unroll
    for (int d0 = 0; d0 < 2; ++d0)
#pragma unroll
        for (int g4 = 0; g4 < 4; ++g4) {
            h16* op = T.orow + 32 * d0 + 8 * g4 + 4 * hi;
            float v0 = o[d0][4 * g4 + 0] * wc, v1 = o[d0][4 * g4 + 1] * wc, v2 = o[d0][4 * g4 + 2] * wc, v3 = o[d0][4 * g4 + 3] * wc;
            if (T.mode == 1 || T.mode == 2) { const u32x2 ov = oold[d0][g4]; v0 += wo * bflo(ov.x); v1 += wo * bfhi(ov.x); v2 += wo * bflo(ov.y); v3 += wo * bfhi(ov.y); }
            u32x2 w; w.x = pkb(v0, v1); w.y = pkb(v2, v3); *(u32x2*)op = w;
        }
    if ((T.mode == 0 || T.mode == 1) && hi == 0) *T.lsep = lse;
}

constexpr int BAND_K = 0, BAND_V = KVImg<256>::KBYTES, BAND_LUT = BAND_V + KVImg<256>::VBYTES, BAND_HALF = BAND_LUT + 4 * 768;
static_assert(2 * BAND_HALF <= LDS_SCR, "band LDS");
struct WinRegs { u32x4 k[8], v[8]; };
__device__ __forceinline__ void win_load(WinRegs& W, const h16* base, long grow0, int gstride, int ld, int kcol, int vcol, bool has_prev, int th, bool real) {
    const int c = th & 7, r0 = th >> 3;
#pragma unroll
    for (int z = 0; z < 8; ++z) { const bool ok = real && (has_prev || z >= 4); const int row = ok ? (r0 + 32 * z) : 128;
        const h16* g = base + (size_t)(grow0 + (long)row * gstride) * ld + (ok ? c * 8 : 0);
        W.k[z] = *(const u32x4*)(g + kcol); W.v[z] = *(const u32x4*)(g + vcol); }
}
__device__ __forceinline__ void win_store(const WinRegs& W, LAS unsigned char* Kimg, LAS unsigned char* Vimg, int th) {
    const int c = th & 7, r0 = th >> 3;
#pragma unroll
    for (int z = 0; z < 8; ++z) { const int row = r0 + 32 * z;
        *(LAS u32x4*)(Kimg + c * KVImg<256>::KCH + row * 16) = W.k[z];
        *(LAS u32x4*)(Vimg + (c >> 2) * KVImg<256>::VDH + row * 64 + (c & 3) * 16) = W.v[z]; }
}

struct SubA { long rowbase; int jb, h; };
__device__ __forceinline__ SubA decode_A(int sub, int dil, int nblk) { SubA d; d.jb = sub % nblk; int t = sub / nblk; d.h = t & 7; t >>= 3; const int r = t % dil, b = t / dil; d.rowbase = (long)b * SEQ + r; return d; }
struct BlkRegs { u32x4 k[4], v[4]; };
__device__ __forceinline__ void blk_load(BlkRegs& R, const h16* base, long grow0, int gstride, bool real, int th) {
    const int c = th & 7, r0 = th >> 3;
#pragma unroll
    for (int z = 0; z < 4; ++z) { const int row = real ? (r0 + 32 * z) : 0;
        const h16* g = base + (size_t)(grow0 + (long)row * gstride) * 64 + (real ? c * 8 : 0);
        R.k[z] = *(const u32x4*)g; R.v[z] = *(const u32x4*)(g + KV_TS); }
}
__device__ __forceinline__ void blk_store(const BlkRegs& R, LAS unsigned char* Kimg, LAS unsigned char* Vimg, int slot, int th) {
    const int c = th & 7, r0 = th >> 3;
#pragma unroll
    for (int z = 0; z < 4; ++z) { const int row = 128 * slot + r0 + 32 * z;
        *(LAS u32x4*)(Kimg + c * KVImg<256>::KCH + row * 16) = R.k[z];
        *(LAS u32x4*)(Vimg + (c >> 2) * KVImg<256>::VDH + row * 64 + (c & 3) * 16) = R.v[z]; }
}
__device__ __forceinline__ void phase_band_A(const Args& a, unsigned char* ws, LAS unsigned char* lds, int vcu, int G, int tid, int wave, int lane, int dil, int mode) {
    const int half = wave >> 2, wq = wave & 3, th = tid & 255;
    LAS unsigned char* hb = lds + half * BAND_HALF;
    const h16* P = big_view(ws, vcu >> 5, PJP); h16* O = (h16*)(ws + WS_O); float* LSE = (float*)(ws + WS_LSE); const float* lutg = (const float*)(ws + WS_LUT);
    const int nblk = (SEQ / dil) / 128;
    const int grp = vcu >> 5, rnk = vcu & 31; const int S0 = 256 * grp + 4 * (2 * rnk + half);
    BlkRegs RA, RB; BandPre pre;
#define A_KBASE(d) kv_rows(ws, grp, T_KA, (int)((d).rowbase >> 11), (d).h)
#define A_OWN(d) ((d).rowbase + (long)(128 * (d).jb) * dil)
#define A_QROW(d) ((d).rowbase + (long)(128 * (d).jb + 32 * wq + (lane & 31)) * dil)
    { const SubA d0 = decode_A(S0, dil, nblk);
      blk_load(RA, A_KBASE(d0), A_OWN(d0) - (d0.jb > 0 ? (long)128 * dil : 0), dil, d0.jb > 0, th);
      blk_load(RB, A_KBASE(d0), A_OWN(d0), dil, true, th);
      band_prefetch(pre, P + (size_t)A_QROW(d0) * PJP + PJ_QA + 64 * d0.h, lutg + d0.h * LUTP, dil, 128, lane);
      blk_store(RA, hb + BAND_K, hb + BAND_V, 1, th); blk_store(RB, hb + BAND_K, hb + BAND_V, 0, th);
      __syncthreads();
      const SubA d1 = decode_A(S0 + 1, dil, nblk), d2 = decode_A(S0 + 2, dil, nblk);
      blk_load(RA, A_KBASE(d1), A_OWN(d1), dil, true, th); blk_load(RB, A_KBASE(d2), A_OWN(d2), dil, true, th); }
    for (int pp = 0; pp < 2; ++pp) {
        const SubA dk = decode_A(S0 + 2 * pp, dil, nblk), dk1 = decode_A(S0 + 2 * pp + 1, dil, nblk);
        const SubA dk2 = decode_A(S0 + (pp == 0 ? 2 : 3), dil, nblk), dk3 = decode_A(S0 + 3, dil, nblk);
        {
            const long qtok = A_QROW(dk);
            BandTask T; T.orow = O + (size_t)qtok * DM + 64 * dk.h; T.lsep = LSE + (size_t)qtok * 8 + dk.h; T.mode = mode; T.sink2 = 0.f; T.qsub = wq; T.has_prev = dk.jb > 0; T.flip = 128;
            band_task(T, pre, hb + BAND_K, hb + BAND_V, (LAS float*)(hb + BAND_LUT + wq * 768), lane);
            band_prefetch(pre, P + (size_t)A_QROW(dk1) * PJP + PJ_QA + 64 * dk1.h, lutg + dk1.h * LUTP, dil, 128, lane);
        }
        __syncthreads();
        blk_store(RA, hb + BAND_K, hb + BAND_V, 1, th);
        __syncthreads();
        blk_load(RA, A_KBASE(dk3), A_OWN(dk3), dil, pp == 0, th);
        {
            const long qtok = A_QROW(dk1);
            BandTask T; T.orow = O + (size_t)qtok * DM + 64 * dk1.h; T.lsep = LSE + (size_t)qtok * 8 + dk1.h; T.mode = mode; T.sink2 = 0.f; T.qsub = wq; T.has_prev = dk1.jb > 0; T.flip = 0;
            band_task(T, pre, hb + BAND_K, hb + BAND_V, (LAS float*)(hb + BAND_LUT + wq * 768), lane);
            band_prefetch(pre, P + (size_t)A_QROW(dk2) * PJP + PJ_QA + 64 * dk2.h, lutg + dk2.h * LUTP, dil, 128, lane);
        }
        __syncthreads();
        if (pp == 0) blk_store(RB, hb + BAND_K, hb + BAND_V, 0, th);
        __syncthreads();
    }
#undef A_KBASE
#undef A_OWN
#undef A_QROW
}

__device__ __forceinline__ void phase_band_C(const Args& a, unsigned char* ws, LAS unsigned char* lds, int vcu, int G, int tid, int wave, int lane) {
    const int half = wave >> 2, wq = wave & 3, th = tid & 255;
    LAS unsigned char* hb = lds + half * BAND_HALF;
    const h16* P = big_view(ws, vcu >> 5, OIN); h16* O = (h16*)(ws + WS_O); const float* lutg = (const float*)(ws + WS_LUT);
    WinRegs W; BandPre pre;
    { const int sub = 2 * vcu + half, jb = sub & 15, kvh = (sub >> 4) & 1, b = sub >> 5; const long rowbase = (long)b * SEQ;
        win_load(W, P, rowbase + 128 * (jb - 1), 1, OIN, O_K + 64 * kvh, O_V + 64 * kvh, jb > 0, th, true);
        const long qtok = rowbase + 128 * jb + 32 * wq + (lane & 31);
        band_prefetch(pre, P + (size_t)qtok * OIN + O_Q + 64 * (8 * kvh), lutg + (8 * kvh) * LUTP, 1, 127, lane); }
    {   const int u = vcu;
        const int sub = 2 * u + half;
        const int jb = sub & 15, kvh = (sub >> 4) & 1, b = sub >> 5;
        const long rowbase = (long)b * SEQ;
        win_store(W, hb + BAND_K, hb + BAND_V, th);
        __syncthreads();
        const long qtok = rowbase + 128 * jb + 32 * wq + (lane & 31);
        for (int j = 0; j < 8; ++j) {
            const int h = 8 * kvh + j;
            const BandPre cur = pre;
            { const int hn = (j < 7) ? h + 1 : h; band_prefetch(pre, P + (size_t)qtok * OIN + O_Q + 64 * hn, lutg + hn * LUTP, 1, 127, lane); }
            BandTask T; T.orow = O + (size_t)qtok * DM + 64 * h; T.lsep = nullptr; T.mode = 3; T.sink2 = a.swa_sinks[h] * LOG2E; T.qsub = wq; T.has_prev = jb > 0; T.flip = 0;
            band_task(T, cur, hb + BAND_K, hb + BAND_V, (LAS float*)(hb + BAND_LUT + wq * 768), lane);
        }
        __syncthreads();
    }
}

constexpr int SC_PITCH = 2308;
static_assert(16 * SC_PITCH * 4 <= LDS_SCR, "score LDS");
__device__ __forceinline__ unsigned f2key(float f) { const unsigned u = __builtin_bit_cast(unsigned, f + 0.0f); return (u & 0x80000000u) ? ~u : (u | 0x80000000u); }
__device__ __forceinline__ void transpose32(unsigned (&x)[32]) {
#define TR_STAGE(D, MD) _Pragma("unroll") for (int i = 0; i < 32; ++i) if (!(i & (D))) { const unsigned a_ = x[i], b_ = x[i + (D)]; \
        x[i] = (a_ & ~(MD)) | ((b_ << (D)) & (MD)); x[i + (D)] = (b_ & (MD)) | ((a_ >> (D)) & ~(MD)); }
    TR_STAGE(16, 0xFFFF0000u) TR_STAGE(8, 0xFF00FF00u) TR_STAGE(4, 0xF0F0F0F0u) TR_STAGE(2, 0xCCCCCCCCu) TR_STAGE(1, 0xAAAAAAAAu)
#undef TR_STAGE
}
__device__ __forceinline__ unsigned bits_shuffle(unsigned x) {
    unsigned t;
    t = (x ^ (x >> 8)) & 0x0000FF00u; x ^= t ^ (t << 8); t = (x ^ (x >> 4)) & 0x00F000F0u; x ^= t ^ (t << 4);
    t = (x ^ (x >> 2)) & 0x0C0C0C0Cu; x ^= t ^ (t << 2); t = (x ^ (x >> 1)) & 0x22222222u; x ^= t ^ (t << 1);
    return x;
}
__device__ __forceinline__ unsigned bits_unshuffle(unsigned x) {
    unsigned t;
    t = (x ^ (x >> 1)) & 0x22222222u; x ^= t ^ (t << 1); t = (x ^ (x >> 2)) & 0x0C0C0C0Cu; x ^= t ^ (t << 2);
    t = (x ^ (x >> 4)) & 0x00F000F0u; x ^= t ^ (t << 4); t = (x ^ (x >> 8)) & 0x0000FF00u; x ^= t ^ (t << 8);
    return x;
}
__device__ __forceinline__ unsigned tie_lowest(unsigned alive, int need, int lane) {
    const int c = __popc(alive);
    int inc = c;
    inc += __builtin_amdgcn_update_dpp(0, inc, 0x111, 0xf, 0xf, true); inc += __builtin_amdgcn_update_dpp(0, inc, 0x112, 0xf, 0xf, true);
    inc += __builtin_amdgcn_update_dpp(0, inc, 0x114, 0xf, 0xf, true); inc += __builtin_amdgcn_update_dpp(0, inc, 0x118, 0xf, 0xf, true);
    const int t0 = __builtin_amdgcn_readlane(inc, 15), t1 = __builtin_amdgcn_readlane(inc, 31), t2 = __builtin_amdgcn_readlane(inc, 47);
    const int row = lane >> 4;
    const int pre = inc - c + (row >= 1 ? t0 : 0) + (row >= 2 ? t1 : 0) + (row >= 3 ? t2 : 0);
    const int r = need - pre;
    if (r <= 0) return 0u;
    if (r >= c) return alive;
    const unsigned wk = bits_shuffle(alive); int lo = 0;
#pragma unroll
    for (int step = 16; step >= 1; step >>= 1) { const int t = lo + step; if (__popc(wk & ((1u << t) - 1u)) < r) lo = t; }
    return bits_unshuffle(wk & ((2u << lo) - 1u));
}
__device__ __forceinline__ float relu1(float x) { return __builtin_amdgcn_fmed3f(x, 0.0f, 3.0e38f); }
__device__ __forceinline__ float key2f(unsigned k) { const unsigned u = (k & 0x80000000u) ? (k ^ 0x80000000u) : ~k; return __builtin_bit_cast(float, u); }
struct SelOps { h16x8 qi[8]; h16x8 w8; h16x8 kf[16]; };
__device__ __forceinline__ void sel_load(SelOps& S, const h16* P, const h16* QB, long rowb, int qt, int wave, int q16, int g4) {
    const int t0 = 16 * qt;
    const h16* qrow = QB + (size_t)(rowb + t0 + q16) * QBW + 512 + 8 * g4;
#pragma unroll
    for (int h = 0; h < 8; ++h) S.qi[h] = *(const h16x8*)(qrow + 32 * h);
    S.w8 = *(const h16x8*)(P + (size_t)(rowb + t0 + q16) * PJP + PJ_WI);
    const h16* kbase = P + (size_t)(rowb + q16) * PJP + PJ_KI + 8 * g4;
#pragma unroll
    for (int z = 0; z < 16; ++z) { const int kt = wave + 8 * z; if (kt <= qt) S.kf[z] = *(const h16x8*)(kbase + (size_t)(16 * kt) * PJP); }
}
__device__ __forceinline__ void phase_select(const Args& a, unsigned char* ws, LAS unsigned char* lds, int vcu, int G, int tid, int wave, int lane) {
    const h16* P = big_view(ws, vcu >> 5, PJP); const h16* QB = (const h16*)(ws + WS_QB); unsigned* BMP = (unsigned*)(ws + WS_BM);
    LAS unsigned* sc = (LAS unsigned*)lds;
    const int q16 = lane & 15, g4 = lane >> 4;
    const int b = vcu >> 4, j = vcu & 15; const long rowb = (long)b * SEQ;
    SelOps ops; sel_load(ops, P, QB, rowb, j, wave, q16, g4);
    for (int i = 0; i < 8; ++i) {
        {
            const int qt = (i & 1) ? (32 * (i >> 1) + 31 - j) : (32 * (i >> 1) + j);
            const int t0 = 16 * qt;
            { float wv[8];
#pragma unroll
              for (int h = 0; h < 8; ++h) wv[h] = (float)ops.w8[h];
#pragma unroll
              for (int z = 0; z < 16; ++z) { const int kt = wave + 8 * z;
                  if (kt <= qt) {
                      f32x4 sacc = {0.f, 0.f, 0.f, 0.f}; f32x4 dh[8];
#pragma unroll
                      for (int h = 0; h < 8; ++h) { const f32x4 zz = {0.f, 0.f, 0.f, 0.f}; dh[h] = __builtin_amdgcn_mfma_f32_16x16x32_f16(ops.kf[z], ops.qi[h], zz, 0, 0, 0); }
#pragma unroll
                      for (int h = 0; h < 8; ++h)
#pragma unroll
                          for (int e = 0; e < 4; ++e) sacc[e] += wv[h] * relu1(dh[h][e]);
                      u32x4 kk; kk.x = f2key(sacc[0]); kk.y = f2key(sacc[1]); kk.z = f2key(sacc[2]); kk.w = f2key(sacc[3]);
                      *(LAS u32x4*)(sc + q16 * SC_PITCH + 16 * kt + 4 * g4 + 4 * (kt >> 1)) = kk;
                  } } }
            if (i < 7) { const int qn = ((i + 1) & 1) ? (32 * ((i + 1) >> 1) + 31 - j) : (32 * ((i + 1) >> 1) + j); sel_load(ops, P, QB, rowb, qn, wave, q16, g4); }
            __syncthreads();
            {
                const int rowA = 2 * wave, tA = t0 + rowA, tB = tA + 1;
                int nvA = tA - 32 * lane + 1; nvA = nvA < 0 ? 0 : (nvA > 32 ? 32 : nvA); int nvB = tB - 32 * lane + 1; nvB = nvB < 0 ? 0 : (nvB > 32 ? 32 : nvB);
                const unsigned admA = ((1u << ((nvA + 1) >> 1)) - 1u) | (((1u << (nvA >> 1)) - 1u) << 16);
                const unsigned admB = ((1u << ((nvB + 1) >> 1)) - 1u) | (((1u << (nvB >> 1)) - 1u) << 16);
                unsigned selA = admA, selB = admB;
                if (tB >= 256) {
                    unsigned ka[32], kb[32];
#pragma unroll
                    for (int i8 = 0; i8 < 8; ++i8) { const u32x4 va = *(const LAS u32x4*)(sc + rowA * SC_PITCH + 36 * lane + 4 * i8); const u32x4 vb = *(const LAS u32x4*)(sc + (rowA + 1) * SC_PITCH + 36 * lane + 4 * i8);
#pragma unroll
                        for (int e = 0; e < 4; ++e) { ka[16 * (e & 1) + 2 * i8 + (e >> 1)] = va[e]; kb[16 * (e & 1) + 2 * i8 + (e >> 1)] = vb[e]; } }
                    transpose32(ka); transpose32(kb);
                    unsigned alA = admA, alB = admB; selA = 0u; selB = 0u;
                    int needA = 256, needB = 256; int doneA = 0, doneB = 0;
#pragma unroll
                    for (int bb = 31; bb >= 0; --bb) {
                        const unsigned oa = alA & ka[bb], ob = alB & kb[bb];
                        int c = __popc(oa) + (__popc(ob) << 16);
                        c += __builtin_amdgcn_update_dpp(0, c, 0x111, 0xf, 0xf, true); c += __builtin_amdgcn_update_dpp(0, c, 0x112, 0xf, 0xf, true);
                        c += __builtin_amdgcn_update_dpp(0, c, 0x114, 0xf, 0xf, true); c += __builtin_amdgcn_update_dpp(0, c, 0x118, 0xf, 0xf, true);
                        const unsigned tot = (unsigned)(__builtin_amdgcn_readlane(c, 15) + __builtin_amdgcn_readlane(c, 31) + __builtin_amdgcn_readlane(c, 47) + __builtin_amdgcn_readlane(c, 63));
                        const int nA = (int)(tot & 0xFFFFu), nB = (int)(tot >> 16);
                        { const unsigned ge = (unsigned)(nA >= needA), eq = (unsigned)(nA == needA); const unsigned mNT = ge - 1u, mKeep = eq - 1u;
                          selA |= oa & (mNT | ~mKeep); alA = alA & (ka[bb] ^ mNT) & mKeep; needA -= (int)(mNT & (unsigned)nA); doneA |= (int)eq; }
                        { const unsigned ge = (unsigned)(nB >= needB), eq = (unsigned)(nB == needB); const unsigned mNT = ge - 1u, mKeep = eq - 1u;
                          selB |= ob & (mNT | ~mKeep); alB = alB & (kb[bb] ^ mNT) & mKeep; needB -= (int)(mNT & (unsigned)nB); doneB |= (int)eq; }
                        if (doneA & doneB) break;
                    }
                    if (!doneA) selA |= tie_lowest(alA, needA, lane);
                    if (!doneB) selB |= tie_lowest(alB, needB, lane);
                }
                unsigned* bmA = BMP + (size_t)(rowb + tA) * 64;
                bmA[lane] = selA; bmA[64 + lane] = selB;
            }
            __syncthreads();
        }
    }
}

constexpr int B2_K = 0, B2_V = 2 * KVImg<128>::KBYTES, B2_LUT = B2_V + 2 * KVImg<128>::VBYTES, B2_END = B2_LUT + 4 * 2080 * 4;
static_assert(B2_END <= LDS_SCR, "B2 LDS");
__device__ __forceinline__ void phase_dsa(const Args& a, unsigned char* ws, LAS unsigned char* lds, int vcu, int G, int tid, int wave, int lane) {
    const h16* QB = (const h16*)(ws + WS_QB); const unsigned* BMP = (const unsigned*)(ws + WS_BM);
    h16* O = (h16*)(ws + WS_O); const float* lutg = (const float*)(ws + WS_LUT); const u64* sscq = (const u64*)(ws + WS_SS) + 7 * (size_t)M;
    const int r32 = lane & 31, hi = lane >> 5;
    { const int c_ = (vcu & 31) >> 3; float tv_[17];
#pragma unroll
      for (int t = 0; t < 17; ++t) { const int x = tid + NTHREADS * t; const int u_ = x / 2080, y = x - u_ * 2080; const int h_ = (4 * u_ + c_) & 7;
          tv_[t] = (x < 4 * 2080 && y >= 32) ? lutg[(8 + h_) * LUTP + y - 32] : 0.f; }
#pragma unroll
      for (int t = 0; t < 17; ++t) { const int x = tid + NTHREADS * t; if (x < 4 * 2080) ((LAS float*)(lds + B2_LUT))[x] = tv_[t]; } }
    for (int i = 0; i < 4; ++i)
        {
            const int grp_ = vcu >> 5, rnk_ = vcu & 31; const int bhl = 4 * i + (rnk_ >> 3), j8 = rnk_ & 7;
            const int b = 2 * grp_ + (bhl >> 3), h = bhl & 7;
            const int qb = (i == 0) ? j8 : (i == 1) ? 7 - j8 : (i == 2) ? ((j8 + 4) & 7) : 7 - ((j8 + 4) & 7);
            const long rowb = (long)b * SEQ; const int q0w = 256 * qb + 32 * wave; const int tq = q0w + r32; const long qtok = rowb + tq;
            const LAS float* lut = (const LAS float*)(lds + B2_LUT) + 2080 * i;
            h16x8 qf[4];
#pragma unroll
            for (int ks = 0; ks < 4; ++ks) qf[ks] = *(const h16x8*)(QB + (size_t)qtok * QBW + 64 * h + ks * 16 + hi * 8);
            const float scl = __builtin_amdgcn_rsqf(ss_val(sscq[qtok]) * (1.0f / 256.0f) + EPS) * QSCALE2;
            const int nch = 2 * qb + 2;
            const h16* P = kv_rows(ws, vcu >> 5, T_KB, b, h);
            const int bhn_ = 4 * (i + 1) + (rnk_ >> 3); const int bn_ = 2 * grp_ + ((bhn_ >> 3) & 1); const h16* Pn = kv_rows(ws, vcu >> 5, T_KB, bn_, bhn_ & 7); const long rowbn = (long)bn_ * SEQ;
            if (i == 0) { fill_kv<128>(lds + B2_K, lds + B2_V, P, rowb, 1, 64, 0, KV_TS, 0, 128, tid, NTHREADS); __syncthreads(); }
#pragma unroll
            for (int ks = 0; ks < 4; ++ks)
#pragma unroll
                for (int e = 0; e < 8; e += 2) { const unsigned w = pkh((float)qf[ks][e] * scl, (float)qf[ks][e + 1] * scl); const h16x2 hh = __builtin_bit_cast(h16x2, w); qf[ks][e] = hh[0]; qf[ks][e + 1] = hh[1]; }
            float mref = 0.f, lrun = 0.f; f32x16 o[2]; o[0] = f32x16{}; o[1] = f32x16{}; bool first = true;
            const int laneb = r32 - 4 * hi + 5;
            u32x4 bwn = *(const u32x4*)(BMP + (size_t)qtok * 64);
            for (int c = 0; c < nch; ++c) {
                const LAS unsigned char* Kimg = lds + B2_K + (c & 1) * KVImg<128>::KBYTES; const LAS unsigned char* Vimg = lds + B2_V + (c & 1) * KVImg<128>::VBYTES;
                u32x4 pk[2], pv[2];
                const bool more = c + 1 < nch; const bool nextu = !more && i < 3;
                if (more || nextu) {
                    const h16* gb = more ? P + (size_t)(rowb + 128 * (c + 1)) * 64 : Pn + (size_t)rowbn * 64;
#pragma unroll
                    for (int z = 0; z < 2; ++z) { const int p = tid + z * NTHREADS; const int row = p >> 3, cc = p & 7; const h16* g = gb + (size_t)row * 64 + cc * 8;
                        pk[z] = *(const u32x4*)g; pv[z] = *(const u32x4*)(g + KV_TS); }
                }
                const u32x4 bw = bwn; if (more) bwn = *(const u32x4*)(BMP + (size_t)qtok * 64 + 4 * (c + 1));
                const LAS float* lp0 = lut + laneb + (q0w - 128 * c);
                const LAS unsigned char* kp0 = Kimg + hi * KVImg<128>::KCH + r32 * 16;
                float lv[16]; h16x8 kf[4];
#pragma unroll
                for (int r = 0; r < 16; ++r) lv[r] = lp0[27 - crow_c(r)];
#pragma unroll
                for (int ks = 0; ks < 4; ++ks) kf[ks] = *(const LAS h16x8*)(kp0 + 2 * ks * KVImg<128>::KCH);
#pragma unroll
                for (int j = 0; j < 4; ++j) {
                    const int k0 = 128 * c + 32 * j;
                    if (k0 <= q0w) {
                        f32x16 acc;
#pragma unroll
                        for (int r = 0; r < 16; ++r) acc[r] = lv[r] - mref;
#pragma unroll
                        for (int ks = 0; ks < 4; ++ks) acc = __builtin_amdgcn_mfma_f32_32x32x16_f16(kf[ks], qf[ks], acc, 0, 0, 0);
                        if (j < 3) {
#pragma unroll
                            for (int r = 0; r < 16; ++r) lv[r] = lp0[27 - 32 * (j + 1) - crow_c(r)];
#pragma unroll
                            for (int ks = 0; ks < 4; ++ks) kf[ks] = *(const LAS h16x8*)(kp0 + 512 * (j + 1) + 2 * ks * KVImg<128>::KCH);
                        }
                        h16x4 vlo[2][2], vhi[2][2];
                        { const LAS unsigned char* vp = Vimg + (32 * j + 4 * hi + ((lane & 15) >> 2)) * 64 + ((lane >> 4) & 1) * 32 + (lane & 3) * 8;
#pragma unroll
                          for (int sx = 0; sx < 2; ++sx)
#pragma unroll
                              for (int d0 = 0; d0 < 2; ++d0) { vlo[sx][d0] = vtr(vp + d0 * KVImg<128>::VDH + sx * 1024); vhi[sx][d0] = vtr(vp + d0 * KVImg<128>::VDH + sx * 1024 + 512); } }
                        const s16x2 wsh = __builtin_bit_cast(s16x2, bw[j] >> (2 * hi));
                        f32x16 s = acc; float mx = -INFINITY;
#pragma unroll
                        for (int r = 0; r < 16; ++r) mx = fmaxf(mx, s[r]);
                        mx = xhalf_max(mx);
                        if (first || __any(mx > 8.0f)) {
                            const float dl = first ? mx : fmaxf(mx, 0.f); first = false;
                            mref += dl; const float alpha = ex2(-dl); lrun *= alpha;
#pragma unroll
                            for (int r = 0; r < 16; ++r) { s[r] -= dl; o[0][r] *= alpha; o[1][r] *= alpha; }
                        }
                        float ls = 0.f; unsigned pp[8];
                        const h16x2 ones2 = {(h16)1.0f, (h16)1.0f};
#pragma unroll
                        for (int pr = 0; pr < 8; ++pr) {
                            const unsigned pw = pkh(ex2(s[2 * pr]), ex2(s[2 * pr + 1]));
                            const s16x2 mk = (wsh << (short)(15 - (4 * (pr >> 1) + (pr & 1)))) >> (short)15;
                            const unsigned pm = pw & __builtin_bit_cast(unsigned, mk);
                            pp[pr] = pm; ls = __builtin_amdgcn_fdot2(__builtin_bit_cast(h16x2, pm), ones2, ls, false);
                        }
                        lrun += ls;
#pragma unroll
                        for (int sx = 0; sx < 2; ++sx) {
                            const u32x4 pw4 = {pp[4 * sx + 0], pp[4 * sx + 1], pp[4 * sx + 2], pp[4 * sx + 3]};
                            const h16x8 pf = __builtin_bit_cast(h16x8, pw4);
#pragma unroll
                            for (int d0 = 0; d0 < 2; ++d0) {
                                const h16x8 vf = {vlo[sx][d0][0], vlo[sx][d0][1], vlo[sx][d0][2], vlo[sx][d0][3], vhi[sx][d0][0], vhi[sx][d0][1], vhi[sx][d0][2], vhi[sx][d0][3]};
                                o[d0] = __builtin_amdgcn_mfma_f32_32x32x16_f16(vf, pf, o[d0], 0, 0, 0);
                            }
                        }
                    }
                }
                if (more || nextu) {
                    LAS unsigned char* Kn = lds + B2_K + ((c + 1) & 1) * KVImg<128>::KBYTES; LAS unsigned char* Vn = lds + B2_V + ((c + 1) & 1) * KVImg<128>::VBYTES;
#pragma unroll
                    for (int z = 0; z < 2; ++z) { const int p = tid + z * NTHREADS; const int row = p >> 3, cc = p & 7;
                        *(LAS u32x4*)(Kn + cc * KVImg<128>::KCH + row * 16) = pk[z]; *(LAS u32x4*)(Vn + (cc >> 2) * KVImg<128>::VDH + row * 64 + (cc & 3) * 16) = pv[z]; }
                }
                __syncthreads();
            }
            const float inv = 1.0f / xhalf_sum(lrun);
            h16* orow = O + (size_t)qtok * DM + 512 + 64 * h;
#pragma unroll
            for (int d0 = 0; d0 < 2; ++d0)
#pragma unroll
                for (int g4 = 0; g4 < 4; ++g4) { u32x2 w; w.x = pkb(o[d0][4 * g4 + 0] * inv, o[d0][4 * g4 + 1] * inv); w.y = pkb(o[d0][4 * g4 + 2] * inv, o[d0][4 * g4 + 3] * inv);
                    *(u32x2*)(orow + 32 * d0 + 8 * g4 + 4 * hi) = w; }
        }
}

__global__ void __launch_bounds__(NTHREADS, 2) fwd_kernel(Args args) {
    extern __shared__ __attribute__((aligned(16))) unsigned char lds_raw[];
    {   LAS unsigned char* lds0 = (LAS unsigned char*)lds_raw;
        for (int u = threadIdx.x; u < (LDS_BYTES - LDSCTL_OFF) / 4; u += NTHREADS) ((LAS unsigned*)(lds0 + LDSCTL_OFF))[u] = 0u;
        __syncthreads();
        if (!MK_PER_PHASE) { xcd_barrier_post((unsigned*)((gu32*)(args.ws + WS_CTL) + CW_BAR)); xcd_barrier_post((unsigned*)((gu32*)(args.ws + WS_CTL) + CW_BAR) + (1 + (blockIdx.x & 7)) * XCD_BAR_WORDS); }
    }
    const int lo = args.ph_lo, hi = args.ph_hi;
    int ph = 0;
#define PH_BEGIN(kind) if (ph >= lo && ph < hi) { const int kind_ = (kind); (void)kind_; const unsigned long long pt0_ = MK_PROBE ? __builtin_amdgcn_s_memrealtime() : 0ull; \
        int tid = threadIdx.x; asm volatile("" : "+v"(tid)); const int lane = tid & 63, wave = __builtin_amdgcn_readfirstlane(tid >> 6); \
        GAS unsigned char* wsg_ = (GAS unsigned char*)args.ws; asm volatile("" : "+s"(wsg_)); unsigned char* ws = (unsigned char*)wsg_; \
        LAS unsigned char* lds = (LAS unsigned char*)lds_raw; \
        const int G = gridDim.x, bx = blockIdx.x; const int grp = bx & 7, rnk = bx >> 3; const int vcu = 32 * grp + rnk; (void)rnk; \
        h16* wb = (h16*)(ws + WS_W); h16* XN = (h16*)(ws + WS_XN); h16* OB = (h16*)(ws + WS_O); h16* QBB = (h16*)(ws + WS_QB); u64* SS = (u64*)(ws + WS_SS); \
        (void)lane; (void)wave; (void)vcu; (void)wb; (void)XN; (void)OB; (void)QBB; (void)SS; (void)lds;
#define PH_END   if (!MK_PER_PHASE && ph + 1 < hi) { unsigned* bar0_ = (unsigned*)((gu32*)(ws + WS_CTL) + CW_BAR); \
            if (ph == 0) xcd_barrier<false>(bar0_, (volatile LAS unsigned*)(lds + MISC_OFF) + 8, (unsigned)G); \
            else xcd_barrier<true>(bar0_ + (1 + grp) * XCD_BAR_WORDS, (volatile LAS unsigned*)(lds + MISC_OFF) + 10, (unsigned)(G >> 3)); } \
        if (MK_PROBE && ((MK_PROBE >> kind_) & 1)) { const unsigned long long pt1_ = __builtin_amdgcn_s_memrealtime(); while (__builtin_amdgcn_s_memrealtime() < pt1_ + (pt1_ - pt0_)) __builtin_amdgcn_s_sleep(8); } } ++ph;

    PH_BEGIN(0)
        if (MK_ONLY & 1) prologue(args, ws, lds, vcu * NWAVES + wave, G * NWAVES, wave, lane);
    PH_END

    for (int step = 0; step < 4; ++step) {
        const int l = step >> 1, j = step & 1;
        const int ssi = (l == 0) ? (j == 0 ? 0 : 2) : (j == 0 ? 3 : 5);
        PH_BEGIN(1)
            pg8::Gemm g{XN, wb + (WO_W13 + (size_t)(2 * l + j) * W13_BYTES) / 2, DM, DM, DM}; pg8::StaticOrder S; S.init(2 * FF, grp, rnk);
            pg8::EpiSwiGLU E{big_view(ws, grp, FF), FF, (const LAS float*)(lds + pg8::RT_OFF), 4096 * grp}; const pg8::RinvSrc rs{SS + (size_t)ssi * M, 4096 * grp};
            if (MK_ONLY & 2) pg8::gemm_phase<pg8::EpiSwiGLU, true>(lds, tid, g, S, E, rs);
        PH_END
        PH_BEGIN(2)
            pg8::Gemm g{big_view(ws, grp, FF), wb + (WO_W2 + (size_t)(2 * l + j) * W2_BYTES) / 2, FF, FF, FF}; pg8::StaticOrder S; S.init(DM, grp, rnk);
            pg8::EpiResid E{XN, SS + (size_t)(ssi + 1) * M, 0.5f};
            if (MK_ONLY & 4) pg8::gemm_phase<pg8::EpiResid, true>(lds, tid, g, S, E);
        PH_END
        if (j == 0) {
            const int ssm = ssi + 1;
            PH_BEGIN((l == 0 ? 3 : 11))
                if (!((l == 0 && (MK_SKIP & 8)) || (l == 1 && (MK_SKIP & 16)))) {
                pg8::Gemm g{XN, wb + (l == 0 ? WO_WINE : WO_WINO) / 2, DM, DM, DM}; pg8::StaticOrder S; S.init(l == 0 ? EINP : OIN, grp, rnk);
                const pg8::RinvSrc rs{SS + (size_t)ssm * M, 4096 * grp}; pg8::EpiH16 E{big_view(ws, grp, l == 0 ? PJP : OIN), l == 0 ? PJP : OIN, (const LAS float*)(lds + pg8::RT_OFF), 4096 * grp, l == 0 ? SS + (size_t)7 * M : nullptr, E_CQ_TILE, l == 0 ? kv_base(ws, grp) : nullptr};
                if (MK_ONLY & 8) pg8::gemm_phase<pg8::EpiH16, true>(lds, tid, g, S, E, rs);
                }
            PH_END
            if (l == 0) {
                for (int br = 0; br < 3; ++br) {
                    PH_BEGIN((5 + br))
                        if ((grp & 1) && (MK_ONLY & 32) && !(MK_SKIP & (8 | 1))) phase_band_A(args, ws, lds, vcu, G, tid, wave, lane, br == 0 ? 16 : (br == 1 ? 4 : 1), br);
                        if (!(MK_SKIP & (8 | 2))) {
                            int tid = threadIdx.x; asm volatile("" : "+v"(tid)); const int lane = tid & 63, wave = __builtin_amdgcn_readfirstlane(tid >> 6);
                            if (br == 0) {
                                int kq = 256; asm volatile("" : "+s"(kq));
                                pg8::Gemm g{big_view(ws, grp, PJP) + PJ_CQ, wb + WO_WQ / 2, PJP, 256, kq}; pg8::StaticOrder S; S.init(QBW, grp, rnk);
                                pg8::EpiPlainH16 E{QBB, QBW};
                                if (MK_ONLY & 16) pg8::gemm_phase<pg8::EpiPlainH16, true>(lds, tid, g, S, E);
                            } else if (br == 1) { if (MK_ONLY & 64) phase_select(args, ws, lds, vcu, G, tid, wave, lane); }
                            else { if (MK_ONLY & 128) phase_dsa(args, ws, lds, vcu, G, tid, wave, lane); }
                        }
                        if (!(grp & 1) && (MK_ONLY & 32) && !(MK_SKIP & (8 | 1))) {
                            int tid = threadIdx.x; asm volatile("" : "+v"(tid)); const int lane = tid & 63, wave = __builtin_amdgcn_readfirstlane(tid >> 6);
                            phase_band_A(args, ws, lds, vcu, G, tid, wave, lane, br == 0 ? 16 : (br == 1 ? 4 : 1), br); }
                    PH_END
                }
            } else {
                PH_BEGIN(12)
                    if ((MK_ONLY & 256) && !(MK_SKIP & (16 | 4))) phase_band_C(args, ws, lds, vcu, G, tid, wave, lane);
                PH_END
            }
            PH_BEGIN((l == 0 ? 10 : 13))
                pg8::Gemm g{OB, wb + (l == 0 ? WO_WOUTE : WO_WOUTO) / 2, DM, DM, DM}; pg8::StaticOrder S; S.init(DM, grp, rnk);
                const bool skip = (l == 0 && (MK_SKIP & 8)) || (l == 1 && (MK_SKIP & 16));
                pg8::EpiResid E{XN, SS + (size_t)(ssm + 1) * M, skip ? 0.0f : 1.0f};
                if (MK_ONLY & 512) pg8::gemm_phase<pg8::EpiResid, true>(lds, tid, g, S, E);
            PH_END
        }
    }
    PH_BEGIN(14)
        const u64* ss6 = SS + (size_t)6 * M; const int NGW = 32 * NWAVES; const int mbeg = 4096 * grp + rnk * NWAVES + wave, mend = 4096 * grp + 4096;
        if (MK_ONLY & 1024) for (int m0 = mbeg; m0 < mend; m0 += 4 * NGW) {
            h16x8 hv[4][2]; float rinv[4];
#pragma unroll
            for (int r = 0; r < 4; ++r) { const int m = m0 + r * NGW; if (m < mend) { const h16x8* hr = (const h16x8*)(XN + (size_t)m * DM) + lane; hv[r][0] = hr[0]; hv[r][1] = hr[64]; rinv[r] = ss_val(ss6[m]); } }
            const f32x4* gr = (const f32x4*)args.final_g + 2 * lane; const f32x4 g00 = gr[0], g01 = gr[1], g10 = gr[128], g11 = gr[129];
#pragma unroll
            for (int r = 0; r < 4; ++r) { const int m = m0 + r * NGW; if (m < mend) { const float ri = __builtin_amdgcn_rsqf(rinv[r] * (1.0f / DM) + EPS); f32x4* xr = (f32x4*)(args.out + (size_t)m * DM) + 2 * lane;
#pragma unroll
                for (int jj = 0; jj < 2; ++jj) { const u32x4 v = __builtin_bit_cast(u32x4, hv[r][jj]);
                    xr[128 * jj] = (f32x4){bflo(v[0]), bfhi(v[0]), bflo(v[1]), bfhi(v[1])} * ri * (jj ? g10 : g00); xr[128 * jj + 1] = (f32x4){bflo(v[2]), bfhi(v[2]), bflo(v[3]), bfhi(v[3])} * ri * (jj ? g11 : g01); } } }
        }
    PH_END
#undef PH_BEGIN
#undef PH_END
}
constexpr int N_PHASES = 1 + 4 * 2 + (1 + 3 + 1) + (1 + 1 + 1) + 1;

extern "C" void kernel_launch(void* const* d_in, const int* in_sizes, int n_in, void* d_out, int out_size, void* d_ws, size_t ws_size, hipStream_t stream) {
    static int grid = 0;
    if (grid == 0) {
        if (n_in != 15 || in_sizes[0] != M * DM || out_size != M * DM || ws_size < WS_END) { fprintf(stderr, "kernel_launch: unexpected shapes / workspace (%d inputs, ws %zu)\n", n_in, ws_size); grid = -1; return; }
        int dev = 0, cus = 0, per_cu = 0;
        if (hipGetDevice(&dev) != hipSuccess || hipDeviceGetAttribute(&cus, hipDeviceAttributeMultiprocessorCount, dev) != hipSuccess) { grid = -1; return; }
        if (hipFuncSetAttribute((const void*)fwd_kernel, hipFuncAttributeMaxDynamicSharedMemorySize, LDS_BYTES) != hipSuccess) { fprintf(stderr, "kernel_launch: hipFuncSetAttribute failed\n"); grid = -1; return; }
        if (hipOccupancyMaxActiveBlocksPerMultiprocessor(&per_cu, (const void*)fwd_kernel, NTHREADS, LDS_BYTES) != hipSuccess || per_cu < 1) { fprintf(stderr, "kernel_launch: occupancy query says %d\n", per_cu); }
        (void)hipGetLastError();
        grid = 256; (void)cus;
    }
    if (grid < 0) return;
    if (hipMemsetAsync((char*)d_ws + WS_CTL, 0, CTL_ZERO_BYTES, stream) != hipSuccess) return;
    Args a{};
    a.x = (const float*)d_in[0]; a.norm_g = (const float*)d_in[1]; a.final_g = (const float*)d_in[2]; a.table = (const float*)d_in[3];
    a.w1 = (const float*)d_in[4]; a.w3 = (const float*)d_in[5]; a.w2 = (const float*)d_in[6];
    a.hyb_w_in = (const float*)d_in[7]; a.hyb_cq_g = (const float*)d_in[8]; a.hyb_wq_b = (const float*)d_in[9]; a.hyb_wq_idx = (const float*)d_in[10]; a.hyb_w_out = (const float*)d_in[11];
    a.swa_w_in = (const float*)d_in[12]; a.swa_sinks = (const float*)d_in[13]; a.swa_w_out = (const float*)d_in[14];
    a.out = (float*)d_out; a.ws = (unsigned char*)d_ws;
#if MK_PER_PHASE
    for (int p = 0; p < N_PHASES; ++p) { a.ph_lo = p; a.ph_hi = p + 1; hipLaunchKernelGGL(fwd_kernel, dim3(grid), dim3(NTHREADS), LDS_BYTES, stream, a); }
#else
    a.ph_lo = 0; a.ph_hi = N_PHASES;
    hipLaunchKernelGGL(fwd_kernel, dim3(grid), dim3(NTHREADS), LDS_BYTES, stream, a);
#endif
}
```
